# Optimizing an MI355X kernel written in HIP

```python
import math
import jax, jax.numpy as jnp
from jax import lax
import numpy as np

D_MODEL = 1024
BATCH = 8
SEQ = 2048
DEPTH = 1

NSA_HEADS = 8
NSA_GROUPS = 2
NSA_HPG = NSA_HEADS // NSA_GROUPS
HEAD_DIM = 64
NSA_DIM = NSA_HEADS * HEAD_DIM
NSA_KV_DIM = NSA_GROUPS * HEAD_DIM
CMP_BLOCK = 32
CMP_STRIDE = 16
CMP_HIDDEN = 256
SEL_BLOCK = 64
SEL_TOPN = 16
WINDOW = 512
Q_BLOCK = 128
SEL_Q_BLOCK = 32
FORCE_BONUS = 1.0e4
ATTN_SCALE = HEAD_DIM ** -0.5
RWKV_HEADS = 8
RWKV_HEAD_DIM = 64
RWKV_DIM = RWKV_HEADS * RWKV_HEAD_DIM
LORA_W = 64
LORA_A = 64
LORA_G = 128
RWKV_GN_EPS = 64e-5
N_BUCKETS = 32
MAX_DISTANCE = 128
PEER_HEADS = 8
N_KEYS = 128
N_EXPERTS = N_KEYS * N_KEYS
PEER_KEY_DIM = 128
PEER_HALF = PEER_KEY_DIM // 2
PEER_TOPK = 16
PEER_TOKEN_BLOCK = 128
ALPHA = (2.0 * DEPTH) ** 0.25
BETA = (8.0 * DEPTH) ** -0.25
LN_EPS = 1e-5
NEG = -1e30
RWKV_COLS = 3 * RWKV_DIM + LORA_W + LORA_A + LORA_G
IN_SIZES = (NSA_DIM,) + (NSA_KV_DIM,) * 6 + (3 * NSA_HEADS, RWKV_COLS, 2 * D_MODEL)
D_IN = int(sum(IN_SIZES))
IN_SPLITS = tuple(int(c) for c in np.cumsum(IN_SIZES)[:-1])
RWKV_SPLITS = tuple(int(c) for c in np.cumsum((RWKV_DIM, RWKV_DIM, RWKV_DIM, LORA_W, LORA_A, LORA_G))[:-1])

kernel_name = "nsa_rwkv7_peer_hybrid_deepnorm"


def _layer_norm(x, g, b):
    xf = x.astype(jnp.float32)
    mu = xf.mean(-1, keepdims=True)
    var = jnp.square(xf - mu).mean(-1, keepdims=True)
    return ((xf - mu) * lax.rsqrt(var + LN_EPS) * g + b).astype(x.dtype)


def _t5_bucket(dist):
    max_exact = N_BUCKETS // 2
    d = jnp.maximum(dist, 0)
    large = max_exact + (jnp.log(jnp.maximum(d, 1).astype(jnp.float32) / max_exact)
                         / math.log(MAX_DISTANCE / max_exact) * (N_BUCKETS - max_exact)).astype(jnp.int32)
    large = jnp.minimum(large, N_BUCKETS - 1)
    return jnp.where(d < max_exact, d, large)


def _masked_softmax(logits, mask):
    p = jax.nn.softmax(jnp.where(mask, logits.astype(jnp.float32), NEG), axis=-1)
    return jnp.where(mask, p, 0.0)


def _compress(kv, pos, w1, b1, w2, b2):
    B, S, G, D = kv.shape
    c = kv.reshape(B, S // CMP_STRIDE, CMP_STRIDE, G, D)
    blocks = jnp.concatenate([c[:, :-1], c[:, 1:]], axis=2) + pos[None, None, :, None, :]
    nc = blocks.shape[1]
    flat = blocks.transpose(0, 1, 3, 2, 4).reshape(B, nc, G, CMP_BLOCK * D)
    return jax.nn.gelu(flat @ w1 + b1) @ w2 + b2


def _nsa_compressed(qg, kc, vc, rel_bias):
    S = qg.shape[1]
    nc = kc.shape[1]
    t = jnp.arange(S)
    blk_end = jnp.arange(nc) * CMP_STRIDE + CMP_BLOCK - 1
    dist = t[:, None] - blk_end[None, :]
    mask = dist >= 0
    bias = rel_bias[_t5_bucket(dist)].reshape(S, nc, NSA_GROUPS, NSA_HPG).transpose(2, 3, 0, 1)
    logits = jnp.einsum('bsghd,bcgd->bghsc', qg, kc).astype(jnp.float32) * ATTN_SCALE + bias
    p = _masked_softmax(logits, mask)
    out = jnp.einsum('bghsc,bcgd->bsghd', p.astype(vc.dtype), vc)
    return out, p


def _selection_indices(p_cmp, S):
    nc = p_cmp.shape[-1]
    nsb = S // SEL_BLOCK
    c0 = jnp.arange(nc) * CMP_STRIDE
    s0 = jnp.arange(nsb) * SEL_BLOCK
    overlap = jnp.clip(jnp.minimum(c0[:, None] + CMP_BLOCK, s0[None, :] + SEL_BLOCK)
                       - jnp.maximum(c0[:, None], s0[None, :]), 0, None).astype(jnp.float32) / CMP_BLOCK
    imp = jnp.einsum('bghsc,cj->bgsj', p_cmp, overlap)
    t = jnp.arange(S)
    cur = t // SEL_BLOCK
    j = jnp.arange(nsb)
    forced = (j[None, :] == 0) | (j[None, :] == cur[:, None]) | (j[None, :] == cur[:, None] - 1)
    future = j[None, :] > cur[:, None]
    score = jnp.where(future, NEG, imp + jnp.where(forced, FORCE_BONUS, 0.0))
    n_sel = min(SEL_TOPN, nsb)
    _, idx = lax.top_k(score, n_sel)
    ok = idx <= cur[None, None, :, None]
    return idx, ok


def _nsa_selected(qg, k, v, idx, ok, rel_bias):
    B, S, G, HPG, D = qg.shape
    nsb = S // SEL_BLOCK
    n_sel = idx.shape[-1]
    kb = k.reshape(B, nsb, SEL_BLOCK, G, D).transpose(0, 3, 1, 2, 4)
    vb = v.reshape(B, nsb, SEL_BLOCK, G, D).transpose(0, 3, 1, 2, 4)
    nq = S // SEL_Q_BLOCK
    q_c = qg.reshape(B, nq, SEL_Q_BLOCK, G, HPG, D).transpose(1, 0, 2, 3, 4, 5)
    idx_c = idx.reshape(B, G, nq, SEL_Q_BLOCK, n_sel).transpose(2, 0, 1, 3, 4)
    ok_c = ok.reshape(B, G, nq, SEL_Q_BLOCK, n_sel).transpose(2, 0, 1, 3, 4)
    t_c = jnp.arange(S).reshape(nq, SEL_Q_BLOCK)
    bi = jnp.arange(B)[:, None, None, None]
    gi = jnp.arange(G)[None, :, None, None]
    gi5 = jnp.arange(G)[None, :, None, None, None]
    tbl = rel_bias.reshape(N_BUCKETS, G, HPG)

    def block(args):
        qb, ib, okb, tb = args
        kg = kb[bi, gi, ib]
        vg = vb[bi, gi, ib]
        pos = ib[..., None] * SEL_BLOCK + jnp.arange(SEL_BLOCK)
        dist = tb[None, None, :, None, None] - pos
        mask = (okb[..., None] & (dist >= 0)).reshape(B, G, 1, SEL_Q_BLOCK, n_sel * SEL_BLOCK)
        bias = tbl[_t5_bucket(dist), gi5].transpose(0, 1, 5, 2, 3, 4)
        logits = jnp.einsum('bqghd,bgqnsd->bghqns', qb, kg).astype(jnp.float32) * ATTN_SCALE + bias
        p = _masked_softmax(logits.reshape(B, G, HPG, SEL_Q_BLOCK, n_sel * SEL_BLOCK), mask)
        return jnp.einsum('bghqn,bgqnd->bqghd', p.astype(vg.dtype),
                          vg.reshape(B, G, SEL_Q_BLOCK, n_sel * SEL_BLOCK, D))

    out = lax.map(block, (q_c, idx_c, ok_c, t_c))
    return out.transpose(1, 0, 2, 3, 4, 5).reshape(B, S, G, HPG, D)


def _nsa_window(qg, k, v, rel_bias):
    B, S, G, HPG, D = qg.shape
    nq = S // Q_BLOCK
    span = WINDOW + Q_BLOCK
    kp = jnp.pad(k, ((0, 0), (WINDOW, 0), (0, 0), (0, 0)))
    vp = jnp.pad(v, ((0, 0), (WINDOW, 0), (0, 0), (0, 0)))
    q_c = qg.reshape(B, nq, Q_BLOCK, G, HPG, D).transpose(1, 0, 2, 3, 4, 5)
    tq = jnp.arange(Q_BLOCK)
    sk = jnp.arange(span) - WINDOW
    dist = tq[:, None] - sk[None, :]
    band = (dist >= 0) & (dist < WINDOW)
    bias = rel_bias[_t5_bucket(dist)].reshape(Q_BLOCK, span, G, HPG).transpose(2, 3, 0, 1)

    def block(args):
        i, qb = args
        start = i * Q_BLOCK
        kb = lax.dynamic_slice_in_dim(kp, start, span, axis=1)
        vb = lax.dynamic_slice_in_dim(vp, start, span, axis=1)
        mask = band & ((start + sk) >= 0)[None, :]
        logits = jnp.einsum('bqghd,bkgd->bghqk', qb, kb).astype(jnp.float32) * ATTN_SCALE + bias
        p = _masked_softmax(logits, mask)
        return jnp.einsum('bghqk,bkgd->bqghd', p.astype(vb.dtype), vb)

    out = lax.map(block, (jnp.arange(nq), q_c))
    return out.transpose(1, 0, 2, 3, 4, 5).reshape(B, S, G, HPG, D)


def _nsa(q, k_cmp, v_cmp, k_slc, v_slc, k_win, v_win, gate_logit, rel_bias,
         cmp_pos, cmp_w1, cmp_b1, cmp_w2, cmp_b2):
    B, S, _ = q.shape
    qg = q.reshape(B, S, NSA_GROUPS, NSA_HPG, HEAD_DIM)
    kvs = lambda z: z.reshape(B, S, NSA_GROUPS, HEAD_DIM)
    kc = _compress(kvs(k_cmp), cmp_pos[0], cmp_w1[0], cmp_b1[0], cmp_w2[0], cmp_b2[0])
    vc = _compress(kvs(v_cmp), cmp_pos[1], cmp_w1[1], cmp_b1[1], cmp_w2[1], cmp_b2[1])
    o_cmp, p_cmp = _nsa_compressed(qg, kc, vc, rel_bias)
    idx, ok = _selection_indices(p_cmp, S)
    o_slc = _nsa_selected(qg, kvs(k_slc), kvs(v_slc), idx, ok, rel_bias)
    o_win = _nsa_window(qg, kvs(k_win), kvs(v_win), rel_bias)
    g = jax.nn.sigmoid(gate_logit).reshape(B, S, NSA_GROUPS, NSA_HPG, 3)
    o = g[..., 0:1] * o_cmp + g[..., 1:2] * o_slc + g[..., 2:3] * o_win
    return o.reshape(B, S, NSA_DIM)


def _rwkv7(r, k, v, w_lo, a_lo, g_lo, w0, w2, a0, a2, g2, k_k, k_a, r_k, lnx_g, lnx_b):
    B, S, _ = r.shape
    H, N = RWKV_HEADS, RWKV_HEAD_DIM
    w = -jax.nn.softplus(-(w0 + jnp.tanh(w_lo) @ w2)) - 0.5
    decay = jnp.exp(-jnp.exp(w.astype(jnp.float32)))
    a = jax.nn.sigmoid(a0 + a_lo @ a2)
    g = jax.nn.sigmoid(g_lo) @ g2
    kk = (k * k_k).astype(jnp.float32).reshape(B, S, H, N)
    kk = kk / jnp.maximum(jnp.sqrt(jnp.sum(kk * kk, -1, keepdims=True)), 1e-12)
    k = k * (1.0 + (a - 1.0) * k_a)
    heads = lambda z: z.astype(jnp.float32).reshape(B, S, H, N)
    rh, kh, vh, ah, wh = heads(r), heads(k), heads(v), heads(a), heads(decay)

    def step(state, inp):
        rt, wt, kt, vt, kkt, at = inp
        sa = jnp.einsum('bhvk,bhk->bhv', state, -kkt)
        state = (state * wt[:, :, None, :] + sa[..., None] * (kkt * at)[:, :, None, :]
                 + vt[..., None] * kt[:, :, None, :])
        return state, jnp.einsum('bhvk,bhk->bhv', state, rt)

    seq_first = lambda z: z.transpose(1, 0, 2, 3)
    init = jnp.zeros((B, H, N, N), jnp.float32)
    _, y = lax.scan(step, init, (seq_first(rh), seq_first(wh), seq_first(kh),
                                 seq_first(vh), seq_first(kk), seq_first(ah)))
    y = y.transpose(1, 0, 2, 3)
    mu = y.mean(-1, keepdims=True)
    var = jnp.square(y - mu).mean(-1, keepdims=True)
    y = ((y - mu) * lax.rsqrt(var + RWKV_GN_EPS)).reshape(B, S, RWKV_DIM) * lnx_g + lnx_b
    bonus = (jnp.sum(rh * kh * r_k, -1, keepdims=True) * vh).reshape(B, S, RWKV_DIM)
    return ((y + bonus) * g).astype(r.dtype)


def _peer(x, w_query, sub_keys, u_table, v_table):
    B, S, D = x.shape
    q = (x @ w_query).reshape(B, S, PEER_HEADS, 2, PEER_HALF)
    sc = jnp.einsum('bshpd,hpnd->bshpn', q, sub_keys).astype(jnp.float32)
    s1, i1 = lax.top_k(sc[..., 0, :], PEER_TOPK)
    s2, i2 = lax.top_k(sc[..., 1, :], PEER_TOPK)
    cand = (s1[..., :, None] + s2[..., None, :]).reshape(B, S, PEER_HEADS, PEER_TOPK * PEER_TOPK)
    cand_idx = (i1[..., :, None] * N_KEYS + i2[..., None, :]).reshape(B, S, PEER_HEADS, PEER_TOPK * PEER_TOPK)
    top_s, pos = lax.top_k(cand, PEER_TOPK)
    idx = jnp.take_along_axis(cand_idx, pos, axis=-1)
    gate = jax.nn.softmax(top_s, axis=-1)
    T = B * S
    nb = T // PEER_TOKEN_BLOCK
    xb = x.reshape(nb, PEER_TOKEN_BLOCK, D)
    ib = idx.reshape(nb, PEER_TOKEN_BLOCK, PEER_HEADS * PEER_TOPK)
    gb = gate.reshape(nb, PEER_TOKEN_BLOCK, PEER_HEADS * PEER_TOPK)

    def block(args):
        xt, it, gt = args
        h = jax.nn.gelu(jnp.einsum('ted,td->te', u_table[it], xt).astype(jnp.float32))
        return jnp.einsum('te,ted->td', (gt * h).astype(v_table.dtype), v_table[it])

    out = lax.map(block, (xb, ib, gb))
    return out.reshape(B, S, D).astype(x.dtype)


def _hybrid_layer(x, rel_bias, w_in, token_mu, cmp_pos, cmp_w1, cmp_b1, cmp_w2, cmp_b2,
                  rwkv_w0, rwkv_w2, rwkv_a0, rwkv_a2, rwkv_g2, rwkv_k_k, rwkv_k_a, rwkv_r_k,
                  rwkv_lnx_g, rwkv_lnx_b, w_o_nsa, w_o_rwkv, w_out, ln_mix_g, ln_mix_b,
                  peer_w_query, peer_sub_keys, peer_u, peer_v, ln_ffn_g, ln_ffn_b):
    z = x @ w_in
    q, k_cmp, v_cmp, k_slc, v_slc, k_win, v_win, nsa_gate, rw, merge_gate = jnp.split(z, IN_SPLITS, axis=-1)
    y_nsa = _nsa(q, k_cmp, v_cmp, k_slc, v_slc, k_win, v_win, nsa_gate, rel_bias,
                 cmp_pos, cmp_w1, cmp_b1, cmp_w2, cmp_b2)
    prev = jnp.pad(rw, ((0, 0), (1, 0), (0, 0)))[:, :-1]
    rw = rw + token_mu * (prev - rw)
    r, k, v, w_lo, a_lo, g_lo = jnp.split(rw, RWKV_SPLITS, axis=-1)
    y_rwkv = _rwkv7(r, k, v, w_lo, a_lo, g_lo, rwkv_w0, rwkv_w2, rwkv_a0, rwkv_a2, rwkv_g2,
                    rwkv_k_k, rwkv_k_a, rwkv_r_k, rwkv_lnx_g, rwkv_lnx_b)
    g_nsa, g_rwkv = jnp.split(jax.nn.sigmoid(merge_gate), 2, axis=-1)
    mixed = (g_nsa * (y_nsa @ w_o_nsa) + g_rwkv * (y_rwkv @ w_o_rwkv)) @ w_out
    x = _layer_norm(ALPHA * x + mixed, ln_mix_g, ln_mix_b)
    x = _layer_norm(ALPHA * x + _peer(x, peer_w_query, peer_sub_keys, peer_u, peer_v), ln_ffn_g, ln_ffn_b)
    return x


def setup_inputs(seed: int = 0) -> dict:
    key = jax.random.key(seed)
    ks = iter(jax.random.split(key, 48))
    L, D = DEPTH, D_MODEL

    def nrm(shape, scale):
        return jax.random.normal(next(ks), shape, jnp.float32) * scale

    def unif(shape, lo, hi):
        return jax.random.uniform(next(ks), shape, jnp.float32, lo, hi)

    return {
        "x": nrm((BATCH, SEQ, D), 1.0),
        "ln_in_g": 1.0 + nrm((D,), 0.02),
        "ln_in_b": nrm((D,), 0.02),
        "rel_bias": nrm((N_BUCKETS, NSA_HEADS), 0.1),
        "w_in": nrm((L, D, D_IN), D ** -0.5),
        "token_mu": unif((L, RWKV_COLS), 0.0, 1.0),
        "cmp_pos": nrm((L, 2, CMP_BLOCK, HEAD_DIM), 0.1),
        "cmp_w1": nrm((L, 2, CMP_BLOCK * HEAD_DIM, CMP_HIDDEN), (CMP_BLOCK * HEAD_DIM) ** -0.5),
        "cmp_b1": nrm((L, 2, CMP_HIDDEN), 0.02),
        "cmp_w2": nrm((L, 2, CMP_HIDDEN, HEAD_DIM), CMP_HIDDEN ** -0.5),
        "cmp_b2": nrm((L, 2, HEAD_DIM), 0.02),
        "rwkv_w0": unif((L, RWKV_DIM), -6.5, -1.5),
        "rwkv_w2": nrm((L, LORA_W, RWKV_DIM), 0.5 * LORA_W ** -0.5),
        "rwkv_a0": nrm((L, RWKV_DIM), 0.1),
        "rwkv_a2": nrm((L, LORA_A, RWKV_DIM), LORA_A ** -0.5),
        "rwkv_g2": nrm((L, LORA_G, RWKV_DIM), LORA_G ** -0.5),
        "rwkv_k_k": 1.0 + nrm((L, RWKV_DIM), 0.05),
        "rwkv_k_a": 1.0 + nrm((L, RWKV_DIM), 0.05),
        "rwkv_r_k": nrm((L, RWKV_HEADS, RWKV_HEAD_DIM), 0.1),
        "rwkv_lnx_g": 1.0 + nrm((L, RWKV_DIM), 0.02),
        "rwkv_lnx_b": nrm((L, RWKV_DIM), 0.02),
        "w_o_nsa": nrm((L, NSA_DIM, D), NSA_DIM ** -0.5),
        "w_o_rwkv": nrm((L, RWKV_DIM, D), RWKV_DIM ** -0.5),
        "w_out": nrm((L, D, D), BETA * D ** -0.5),
        "ln_mix_g": 1.0 + nrm((L, D), 0.02),
        "ln_mix_b": nrm((L, D), 0.02),
        "peer_w_query": nrm((L, D, PEER_HEADS * PEER_KEY_DIM), D ** -0.5),
        "peer_sub_keys": nrm((L, PEER_HEADS, 2, N_KEYS, PEER_HALF), PEER_HALF ** -0.5),
        "peer_u": nrm((L, N_EXPERTS, D), D ** -0.5),
        "peer_v": nrm((L, N_EXPERTS, D), BETA * PEER_HEADS ** -0.5),
        "ln_ffn_g": 1.0 + nrm((L, D), 0.02),
        "ln_ffn_b": nrm((L, D), 0.02),
    }


def reference(x, ln_in_g, ln_in_b, rel_bias, w_in, token_mu, cmp_pos, cmp_w1, cmp_b1, cmp_w2, cmp_b2,
              rwkv_w0, rwkv_w2, rwkv_a0, rwkv_a2, rwkv_g2, rwkv_k_k, rwkv_k_a, rwkv_r_k,
              rwkv_lnx_g, rwkv_lnx_b, w_o_nsa, w_o_rwkv, w_out, ln_mix_g, ln_mix_b,
              peer_w_query, peer_sub_keys, peer_u, peer_v, ln_ffn_g, ln_ffn_b):
    h = _layer_norm(x, ln_in_g, ln_in_b)
    for l in range(DEPTH):
        h = _hybrid_layer(h, rel_bias, w_in[l], token_mu[l], cmp_pos[l], cmp_w1[l], cmp_b1[l],
                          cmp_w2[l], cmp_b2[l], rwkv_w0[l], rwkv_w2[l], rwkv_a0[l], rwkv_a2[l],
                          rwkv_g2[l], rwkv_k_k[l], rwkv_k_a[l], rwkv_r_k[l], rwkv_lnx_g[l],
                          rwkv_lnx_b[l], w_o_nsa[l], w_o_rwkv[l], w_out[l], ln_mix_g[l], ln_mix_b[l],
                          peer_w_query[l], peer_sub_keys[l], peer_u[l], peer_v[l],
                          ln_ffn_g[l], ln_ffn_b[l])
    return h
```

```cpp
#include <hip/hip_runtime.h>
#include <hip/hip_cooperative_groups.h>
#include <cstdio>
namespace cg = cooperative_groups;

typedef unsigned short bf16_t;
#define DEV __device__ __forceinline__

constexpr int B_ = 8, S_ = 2048, T_ = B_ * S_, D_ = 1024;
constexpr int DIN = 5144;
constexpr int NZ = 3096;
constexpr int C_MG = 3096;
constexpr int RWC = 1792;
constexpr float ALPHA = 1.189207115002721f;
constexpr float NEGF = -1e30f;

enum { I_X = 0, I_LNIN_G, I_LNIN_B, I_RELB, I_WIN, I_MU, I_CPOS, I_CW1, I_CB1, I_CW2, I_CB2, I_W0, I_W2, I_A0, I_A2, I_G2,
       I_KK, I_KA, I_RK, I_LNXG, I_LNXB, I_WON, I_WOR, I_WOUT, I_LNMG, I_LNMB, I_PWQ, I_PSK, I_PU, I_PV, I_LNFG, I_LNFB };

constexpr size_t MiB = 1ull << 20;
constexpr size_t OFF_HB = 0;
constexpr size_t OFF_Q = OFF_HB + 32 * MiB;
constexpr size_t OFF_KVC = OFF_Q + 16 * MiB;
constexpr size_t OFF_KSLC = OFF_KVC + 8 * MiB;
constexpr size_t OFF_KWIN = OFF_KSLC + 4 * MiB;
constexpr size_t OFF_VSLCT = OFF_KWIN + 4 * MiB;
constexpr size_t OFF_VWINT = OFF_VSLCT + 4 * MiB;
constexpr size_t OFF_GATE = OFF_VWINT + 4 * MiB;
constexpr size_t OFF_KC = OFF_GATE + 1536 * 1024;
constexpr size_t OFF_VCT = OFF_KC + 256 * 1024;
constexpr size_t OFF_YNSA = OFF_VCT + 256 * 1024;
constexpr size_t OFF_YRWKV = OFF_YNSA + 16 * MiB;
constexpr size_t OFF_WTS = OFF_YRWKV + 16 * MiB;
constexpr size_t OFF_SCAN = OFF_WTS + 20 * MiB;
constexpr size_t OFF_R = OFF_SCAN;
constexpr size_t OFF_OMD = OFF_R + 16 * MiB;
constexpr size_t OFF_KP = OFF_OMD + 16 * MiB;
constexpr size_t OFF_V = OFF_KP + 16 * MiB;
constexpr size_t OFF_KB = OFF_V + 16 * MiB;
constexpr size_t OFF_G = OFF_KB + 32 * MiB;
constexpr size_t OFF_END = OFF_G + 16 * MiB;
constexpr size_t OFF_Y = OFF_END;
constexpr size_t W_IN = OFF_WTS;
constexpr size_t W_G = W_IN + 3200 * 1024 * 2;
constexpr size_t W_N = W_G + 2048 * 1024 * 2;
constexpr size_t W_R = W_N + 1024 * 512 * 2;
constexpr size_t W_OUT = W_R + 1024 * 512 * 2;
constexpr size_t W_Q = W_OUT + 1024 * 1024 * 2;
constexpr size_t W_SK = W_Q + 1024 * 1024 * 2;
constexpr size_t W_LW = W_SK + 8 * 2 * 128 * 64 * 2;
constexpr size_t W_LA = W_LW + 512 * 64 * 2;
constexpr size_t W_LG = W_LA + 512 * 64 * 2;
constexpr size_t W_C1T = W_LG + 512 * 128 * 2;
constexpr size_t W_C2T = W_C1T + 2 * 256 * 2048 * 2;
constexpr size_t W_C1 = W_C2T + 2 * 64 * 256 * 2;
constexpr size_t W_END = W_C1 + 2 * 256 * 4;
constexpr size_t OFF_BAR = OFF_WTS + 19 * MiB + 512 * 1024;
static_assert(W_END <= OFF_BAR, "weights region");
constexpr size_t OFF_CTL = OFF_BAR + 14336;
constexpr size_t OFF_MF = OFF_SCAN + 32 * MiB;
constexpr size_t OFF_M = OFF_SCAN;
constexpr size_t OFF_QP = OFF_SCAN;
constexpr size_t OFF_U16 = OFF_SCAN + 32 * MiB;
constexpr size_t OFF_V16 = OFF_SCAN + 64 * MiB;
constexpr size_t OFF_U8 = OFF_SCAN + 32 * MiB;
constexpr size_t OFF_V8 = OFF_SCAN + 48 * MiB;
constexpr size_t OFF_SC8 = OFF_SCAN + 64 * MiB;
constexpr size_t OFF_U6 = OFF_SCAN + 32 * MiB;
constexpr size_t OFF_V6 = OFF_SCAN + 48 * MiB;
constexpr size_t OFF_HW = OFF_SCAN + 72 * MiB;
constexpr size_t OFF_IDX = OFF_Q;
constexpr size_t OFF_GP = OFF_Q + 8 * MiB;

struct Params {
  const float* in[32];
  float* out;
  unsigned char* ws;
};

__device__ const unsigned char T5B[128] = {
  0, 1, 2, 3, 4, 5, 6, 7, 8, 9, 10, 11, 12, 13, 14, 15, 16, 16, 16, 17, 17, 18, 18, 18, 19, 19, 19, 20, 20, 20, 20, 21, 21, 21, 21,
  22, 22, 22, 22, 22, 23, 23, 23, 23, 23, 23, 24, 24, 24, 24, 24, 24, 25, 25, 25, 25, 25, 25, 25, 26, 26, 26, 26, 26, 26, 26, 26,
  27, 27, 27, 27, 27, 27, 27, 27, 27, 27, 28, 28, 28, 28, 28, 28, 28, 28, 28, 28, 29, 29, 29, 29, 29, 29, 29, 29, 29, 29, 29, 29,
  30, 30, 30, 30, 30, 30, 30, 30, 30, 30, 30, 30, 30, 30, 31, 31, 31, 31, 31, 31, 31, 31, 31, 31, 31, 31, 31, 31, 31};

DEV int opaque_tid(int wv) { int l; asm volatile("v_mbcnt_lo_u32_b32 %0, -1, 0\n\tv_mbcnt_hi_u32_b32 %0, -1, %0" : "=v"(l)); return wv * 64 + l; }
DEV float bf2f(bf16_t v) { return __uint_as_float(((unsigned)v) << 16); }
DEV bf16_t f2bf(float f) { unsigned u = __float_as_uint(f); u += 0x7fffu + ((u >> 16) & 1u); return (bf16_t)(u >> 16); }
DEV float sigm(float x) { return 1.f / (1.f + __expf(-x)); }
DEV float gelu_tanh(float x) { float u = 0.7978845608028654f * (x + 0.044715f * x * x * x); return 0.5f * x * (1.f + tanhf(u)); }
#define SWZ_XOR(v, K) __int_as_float(__builtin_amdgcn_ds_swizzle(__float_as_int(v), ((K) << 10) | 0x1F))
DEV float xor32_sum(float v) { auto r = __builtin_amdgcn_permlane32_swap(__float_as_uint(v), __float_as_uint(v), false, false); return __uint_as_float(r[0]) + __uint_as_float(r[1]); }
DEV float xor32_max(float v) { auto r = __builtin_amdgcn_permlane32_swap(__float_as_uint(v), __float_as_uint(v), false, false); return fmaxf(__uint_as_float(r[0]), __uint_as_float(r[1])); }
DEV unsigned xor32_get(unsigned v, int lh) { auto r = __builtin_amdgcn_permlane32_swap(v, v, false, false); return lh ? r[0] : r[1]; }
DEV float wave_sum(float v) { v += SWZ_XOR(v, 1); v += SWZ_XOR(v, 2); v += SWZ_XOR(v, 4); v += SWZ_XOR(v, 8); v += SWZ_XOR(v, 16); return xor32_sum(v); }
DEV float wave_max(float v) { v = fmaxf(v, SWZ_XOR(v, 1)); v = fmaxf(v, SWZ_XOR(v, 2)); v = fmaxf(v, SWZ_XOR(v, 4)); v = fmaxf(v, SWZ_XOR(v, 8)); v = fmaxf(v, SWZ_XOR(v, 16)); return xor32_max(v); }
DEV int t5bucket(int dist) { return T5B[dist > 127 ? 127 : dist]; }

DEV void ph_ln_wave(const float* in, const float* g, const float* b, float* of, bf16_t* ob, int wv) {
  const int tid_ = opaque_tid(wv);
  const int lane = tid_ & 63;
  const int wg = blockIdx.x * 4 + (tid_ >> 6), nw = gridDim.x * 4;
  float4 gg[4], bb[4];
#pragma unroll
  for (int i = 0; i < 4; ++i) { gg[i] = ((const float4*)g)[lane + 64 * i]; bb[i] = ((const float4*)b)[lane + 64 * i]; }
  for (int t = wg; t < T_; t += nw) {
    float4 v[4]; float s = 0.f;
#pragma unroll
    for (int i = 0; i < 4; ++i) { v[i] = ((const float4*)(in + (size_t)t * D_))[lane + 64 * i]; s += v[i].x + v[i].y + v[i].z + v[i].w; }
    const float mu = wave_sum(s) * (1.f / D_);
    float q = 0.f;
#pragma unroll
    for (int i = 0; i < 4; ++i) { v[i].x -= mu; v[i].y -= mu; v[i].z -= mu; v[i].w -= mu; q += v[i].x * v[i].x + v[i].y * v[i].y + v[i].z * v[i].z + v[i].w * v[i].w; }
    const float rs = rsqrtf(wave_sum(q) * (1.f / D_) + 1e-5f);
#pragma unroll
    for (int i = 0; i < 4; ++i) {
      float4 o = make_float4(v[i].x * rs * gg[i].x + bb[i].x, v[i].y * rs * gg[i].y + bb[i].y, v[i].z * rs * gg[i].z + bb[i].z, v[i].w * rs * gg[i].w + bb[i].w);
      if (of) ((float4*)(of + (size_t)t * D_))[lane + 64 * i] = o;
      if (ob) { ushort4 h; h.x = f2bf(o.x); h.y = f2bf(o.y); h.z = f2bf(o.z); h.w = f2bf(o.w); ((ushort4*)(ob + (size_t)t * D_))[lane + 64 * i] = h; }
    }
  }
}

DEV void unpack8(const uint4& u, float (&f)[8]) {
  f[0] = __uint_as_float(u.x << 16); f[1] = __uint_as_float(u.x & 0xffff0000u); f[2] = __uint_as_float(u.y << 16); f[3] = __uint_as_float(u.y & 0xffff0000u);
  f[4] = __uint_as_float(u.z << 16); f[5] = __uint_as_float(u.z & 0xffff0000u); f[6] = __uint_as_float(u.w << 16); f[7] = __uint_as_float(u.w & 0xffff0000u);
}
DEV float sum8lanes(float v) { v += SWZ_XOR(v, 1); v += SWZ_XOR(v, 2); v += SWZ_XOR(v, 4); return v; }
DEV void ph_post_wave(const Params& p, int wv) {
  const int tid_ = opaque_tid(wv);
  const int lane = tid_ & 63;
  const int wg = blockIdx.x * 4 + (tid_ >> 6), nw = gridDim.x * 4;
  const bf16_t* R = (const bf16_t*)(p.ws + OFF_R); const bf16_t* KP = (const bf16_t*)(p.ws + OFF_KP);
  const bf16_t* V = (const bf16_t*)(p.ws + OFF_V); const bf16_t* G = (const bf16_t*)(p.ws + OFF_G);
  const bf16_t* Y = (const bf16_t*)(p.ws + OFF_Y);
  bf16_t* YR = (bf16_t*)(p.ws + OFF_YRWKV);
  float lg[8], lb[8], rk[8];
#pragma unroll
  for (int j = 0; j < 8; ++j) { lg[j] = p.in[I_LNXG][lane * 8 + j]; lb[j] = p.in[I_LNXB][lane * 8 + j]; rk[j] = p.in[I_RK][lane * 8 + j]; }
  for (int t = wg; t < T_; t += nw) {
    const size_t o = (size_t)t * 512 + lane * 8;
    float y[8], r[8], k[8], v[8], g[8];
    unpack8(*(const uint4*)(Y + o), y); unpack8(*(const uint4*)(R + o), r); unpack8(*(const uint4*)(KP + o), k);
    unpack8(*(const uint4*)(V + o), v); unpack8(*(const uint4*)(G + o), g);
    float s = 0.f, dot = 0.f;
#pragma unroll
    for (int j = 0; j < 8; ++j) { s += y[j]; dot += r[j] * k[j] * rk[j]; }
    const float mu = sum8lanes(s) * (1.f / 64.f);
    dot = sum8lanes(dot);
    float q = 0.f;
#pragma unroll
    for (int j = 0; j < 8; ++j) { y[j] -= mu; q += y[j] * y[j]; }
    const float rs = rsqrtf(sum8lanes(q) * (1.f / 64.f) + 64e-5f);
    uint4 ov; unsigned w[4];
#pragma unroll
    for (int j = 0; j < 4; ++j) {
      const float a = (y[2 * j] * rs * lg[2 * j] + lb[2 * j] + dot * v[2 * j]) * g[2 * j];
      const float c = (y[2 * j + 1] * rs * lg[2 * j + 1] + lb[2 * j + 1] + dot * v[2 * j + 1]) * g[2 * j + 1];
      w[j] = (unsigned)f2bf(a) | ((unsigned)f2bf(c) << 16);
    }
    ov.x = w[0]; ov.y = w[1]; ov.z = w[2]; ov.w = w[3];
    *(uint4*)(YR + o) = ov;
  }
}

DEV void conv_wT(const float* src, int ldsrc, int c0, int K, int N, int Npad, bf16_t* dst, float* lds, int& item0, int gsz, int wv) {
  const int tid = opaque_tid(wv);
  const int nt = Npad / 64, kt = K / 64;
  const int nitems = nt * kt;
  for (int item = ((int)blockIdx.x - item0 % gsz + gsz) % gsz; item < nitems; item += gsz) {
    const int n0 = (item % nt) * 64, k0 = (item / nt) * 64;
    __syncthreads();
    for (int e = tid; e < 4096; e += 256) {
      int kk = e >> 6, nn = e & 63;
      lds[kk * 65 + nn] = (n0 + nn < N) ? src[(size_t)(k0 + kk) * ldsrc + c0 + n0 + nn] : 0.f;
    }
    __syncthreads();
    for (int e = tid; e < 512; e += 256) {
      const int nn = e >> 3, kk = (e & 7) * 8;
      uint4 o;
      o.x = (unsigned)f2bf(lds[kk * 65 + nn]) | ((unsigned)f2bf(lds[(kk + 1) * 65 + nn]) << 16);
      o.y = (unsigned)f2bf(lds[(kk + 2) * 65 + nn]) | ((unsigned)f2bf(lds[(kk + 3) * 65 + nn]) << 16);
      o.z = (unsigned)f2bf(lds[(kk + 4) * 65 + nn]) | ((unsigned)f2bf(lds[(kk + 5) * 65 + nn]) << 16);
      o.w = (unsigned)f2bf(lds[(kk + 6) * 65 + nn]) | ((unsigned)f2bf(lds[(kk + 7) * 65 + nn]) << 16);
      *(uint4*)(dst + (size_t)(n0 + nn) * K + k0 + kk) = o;
    }
  }
  item0 += nitems;
}

typedef __attribute__((ext_vector_type(8))) short bf16x8;
typedef __attribute__((ext_vector_type(16))) float f32x16;
typedef __attribute__((ext_vector_type(4))) unsigned u32x4;

DEV int swz(int row, int c) { return row * 128 + ((c ^ ((row >> 1) & 7)) << 4); }

template <bool ZERO = true>
DEV void mfma_gemm_mainloop(const bf16_t* A, int lda, const bf16_t* Bt, int ldb, int K, int m0, int n0, unsigned char* lds, f32x16 (&acc)[2][2], int wv) {
  const int tid = opaque_tid(wv), lane = tid & 63, wm = wv >> 1, wn = wv & 1;
  const int l31 = lane & 31, lh = lane >> 5;
  if (ZERO) {
#pragma unroll
    for (int i = 0; i < 2; ++i)
#pragma unroll
      for (int j = 0; j < 2; ++j)
#pragma unroll
        for (int r = 0; r < 16; ++r) acc[i][j][r] = 0.f;
  }
  const int KT = K / 64;
  typedef __attribute__((address_space(3))) void* ldsp_t;
  const int prow = lane >> 3, pcp = lane & 7;
  unsigned goffA[4], goffB[4];
#pragma unroll
  for (int j = 0; j < 4; ++j) {
    const int row = 8 * (4 * wv + j) + prow, c = pcp ^ ((row >> 1) & 7);
    goffA[j] = (unsigned)(row * lda + c * 8); goffB[j] = (unsigned)(row * ldb + c * 8);
  }
  const bf16_t* Ab = A + (size_t)m0 * lda; const bf16_t* Bb = Bt + (size_t)n0 * ldb;
#define GEMM_GLDS(buf_, kt_) do { _Pragma("unroll") for (int j = 0; j < 4; ++j) { \
      __builtin_amdgcn_global_load_lds((const void*)(Ab + (kt_) * 64 + goffA[j]), (ldsp_t)(lds + (buf_) * 32768 + (4 * wv + j) * 1024), 16, 0, 0); \
      __builtin_amdgcn_global_load_lds((const void*)(Bb + (kt_) * 64 + goffB[j]), (ldsp_t)(lds + (buf_) * 32768 + 16384 + (4 * wv + j) * 1024), 16, 0, 0); } } while (0)
  __syncthreads();
  GEMM_GLDS(0, 0);
  __builtin_amdgcn_sched_barrier(0);
  asm volatile("s_waitcnt vmcnt(0)" ::: "memory");
  __syncthreads();
  __builtin_amdgcn_sched_barrier(0);
  for (int kt = 0; kt < KT; ++kt) {
    if (kt + 1 < KT) GEMM_GLDS((kt + 1) & 1, kt + 1);
    const unsigned char* as = lds + (kt & 1) * 32768; const unsigned char* bs = as + 16384;
#pragma unroll
    for (int s = 0; s < 4; ++s) {
      bf16x8 af[2], bfr[2];
#pragma unroll
      for (int i = 0; i < 2; ++i) {
        af[i] = *(const bf16x8*)(as + swz(wm * 64 + i * 32 + l31, 2 * s + lh));
        bfr[i] = *(const bf16x8*)(bs + swz(wn * 64 + i * 32 + l31, 2 * s + lh));
      }
#pragma unroll
      for (int i = 0; i < 2; ++i)
#pragma unroll
        for (int j = 0; j < 2; ++j) acc[i][j] = __builtin_amdgcn_mfma_f32_32x32x16_bf16(af[i], bfr[j], acc[i][j], 0, 0, 0);
    }
    __builtin_amdgcn_sched_barrier(0);
    asm volatile("s_waitcnt vmcnt(0)" ::: "memory");
    __syncthreads();
    __builtin_amdgcn_sched_barrier(0);
  }
}

template <class Epi>
DEV void mfma_gemm_tile(const bf16_t* A, int lda, const bf16_t* Bt, int ldb, int K, int m0, int n0, unsigned char* lds, Epi& epi, int wv) {
  const int tid = opaque_tid(wv), lane = tid & 63, wm = wv >> 1, wn = wv & 1;
  const int l31 = lane & 31, lh = lane >> 5;
  f32x16 acc[2][2];
  mfma_gemm_mainloop(A, lda, Bt, ldb, K, m0, n0, lds, acc, wv);
#pragma unroll
  for (int i = 0; i < 2; ++i)
#pragma unroll
    for (int j = 0; j < 2; ++j) {
      const int rb = m0 + wm * 64 + i * 32, cb = n0 + wn * 64 + j * 32;
      if (epi.block(rb, cb, l31, lh, acc[i][j])) continue;
#pragma unroll
      for (int r = 0; r < 16; ++r) {
        epi(rb + (r & 3) + 8 * (r >> 2) + 4 * lh, cb + l31, acc[i][j][r]);
        if ((r & 3) == 3) __builtin_amdgcn_sched_barrier(0);
      }
    }
}

typedef __attribute__((ext_vector_type(4))) float f32x4;
template <class Epi>
DEV void mfma_gemm_tile16(const bf16_t* A, int lda, const bf16_t* Bt, int ldb, int K, int m0, int n0, unsigned char* lds, Epi& epi, int wv) {
  const int tid = opaque_tid(wv), lane = tid & 63, wm = wv >> 1, wn = wv & 1;
  const int l15 = lane & 15, lq = lane >> 4;
  f32x4 acc[4][4];
#pragma unroll
  for (int i = 0; i < 4; ++i)
#pragma unroll
    for (int j = 0; j < 4; ++j) acc[i][j] = f32x4{0.f, 0.f, 0.f, 0.f};
  const int KT = K / 64;
  typedef __attribute__((address_space(3))) void* ldsp_t;
  const int prow = lane >> 3, pcp = lane & 7;
  unsigned goffA[4], goffB[4];
#pragma unroll
  for (int j = 0; j < 4; ++j) {
    const int row = 8 * (4 * wv + j) + prow, c = pcp ^ ((row >> 1) & 7);
    goffA[j] = (unsigned)(row * lda + c * 8); goffB[j] = (unsigned)(row * ldb + c * 8);
  }
  const bf16_t* Ab = A + (size_t)m0 * lda; const bf16_t* Bb = Bt + (size_t)n0 * ldb;
  __syncthreads();
  GEMM_GLDS(0, 0);
  __builtin_amdgcn_sched_barrier(0);
  asm volatile("s_waitcnt vmcnt(0)" ::: "memory");
  __syncthreads();
  __builtin_amdgcn_sched_barrier(0);
  for (int kt = 0; kt < KT; ++kt) {
    if (kt + 1 < KT) GEMM_GLDS((kt + 1) & 1, kt + 1);
    const unsigned char* as = lds + (kt & 1) * 32768; const unsigned char* bs = as + 16384;
#pragma unroll
    for (int s = 0; s < 2; ++s) {
      bf16x8 af[4], bfr[4];
#pragma unroll
      for (int i = 0; i < 4; ++i) {
        af[i] = *(const bf16x8*)(as + swz(wm * 64 + i * 16 + l15, 4 * s + lq));
        bfr[i] = *(const bf16x8*)(bs + swz(wn * 64 + i * 16 + l15, 4 * s + lq));
      }
#pragma unroll
      for (int i = 0; i < 4; ++i)
#pragma unroll
        for (int j = 0; j < 4; ++j) acc[i][j] = __builtin_amdgcn_mfma_f32_16x16x32_bf16(af[i], bfr[j], acc[i][j], 0, 0, 0);
    }
    __builtin_amdgcn_sched_barrier(0);
    asm volatile("s_waitcnt vmcnt(0)" ::: "memory");
    __syncthreads();
    __builtin_amdgcn_sched_barrier(0);
  }
#pragma unroll
  for (int i = 0; i < 4; ++i)
#pragma unroll
    for (int j = 0; j < 4; ++j) {
#pragma unroll
      for (int r = 0; r < 4; ++r) epi(m0 + wm * 64 + i * 16 + 4 * lq + r, n0 + wn * 64 + j * 16 + l15, acc[i][j][r]);
      __builtin_amdgcn_sched_barrier(0);
    }
}

template <class Epi>
DEV void mfma_gemm16(const bf16_t* A, int lda, const bf16_t* Bt, int ldb, int K, int M, int N, unsigned char* lds, Epi epi, int wv) {
  const int nt = N / 128, mt = M / 128;
  const int grp = blockIdx.x & 7, slot = blockIdx.x >> 3, nslots = gridDim.x >> 3, mg = mt >> 3;
  for (int l = slot; l < mg * nt; l += nslots)
    mfma_gemm_tile16(A, lda, Bt, ldb, K, (grp * mg + l % mg) * 128, (l / mg) * 128, lds, epi, wv);
}

template <class F> struct ElemEpi { F f; DEV bool block(int, int, int, int, const f32x16&) const { return false; } DEV void operator()(int t, int n, float v) const { f(t, n, v); } };
template <class F> DEV ElemEpi<F> elem_epi(F f) { return ElemEpi<F>{f}; }

template <class Epi>
DEV void mfma_gemm(const bf16_t* A, int lda, const bf16_t* Bt, int ldb, int K, int M, int N, unsigned char* lds, Epi epi, int wv) {
  const int nt = N / 128, mt = M / 128;
  if ((gridDim.x & 7) == 0 && (mt & 7) == 0) {
    const int grp = blockIdx.x & 7, slot = blockIdx.x >> 3, nslots = gridDim.x >> 3, mg = mt >> 3;
    for (int l = slot; l < mg * nt; l += nslots)
      mfma_gemm_tile(A, lda, Bt, ldb, K, (grp * mg + l % mg) * 128, (l / mg) * 128, lds, epi, wv);
  } else {
    const int nitems = mt * nt;
    for (int item = blockIdx.x; item < nitems; item += gridDim.x)
      mfma_gemm_tile(A, lda, Bt, ldb, K, (item / nt) * 128, (item % nt) * 128, lds, epi, wv);
  }
}

struct ZEpi {
  bf16_t *q, *kvc, *kslc, *kwin, *vslct, *vwint, *rw; float* gate;
  DEV static void rows(bf16_t* base, int ld, int lh, const f32x16& a, float scale) {
#pragma unroll
    for (int r = 0; r < 16; ++r) base[(unsigned)(((r & 3) + 8 * (r >> 2) + 4 * lh) * ld)] = f2bf(a[r] * scale);
  }
  DEV bool block(int rb, int cb, int l31, int lh, const f32x16& a) const {
    if (cb < 512) { rows(q + (unsigned)(rb * 512 + cb + l31), 512, lh, a, 0.125f * 1.4426950408889634f); return true; }
    if (cb < 768) { rows(kvc + (unsigned)(rb * 256 + cb - 512 + l31), 256, lh, a, 1.f); return true; }
    if (cb < 896) { rows(kslc + (unsigned)(rb * 128 + cb - 768 + l31), 128, lh, a, 1.f); return true; }
    if (cb >= 1024 && cb < 1152) { rows(kwin + (unsigned)(rb * 128 + cb - 1024 + l31), 128, lh, a, 1.f); return true; }
    if (cb >= 1312 && cb < 3072) { rows(rw + (unsigned)(rb * RWC + cb - 1304 + l31), RWC, lh, a, 1.f); return true; }
    if (cb >= 3104) return true;
    if (cb == 1280 || cb == 3072) return false;
    bf16_t* dst = (cb < 1024) ? vslct : vwint;
    const int c = cb - ((cb < 1024) ? 896 : 1152) + l31;
    bf16_t* base = dst + (unsigned)((((rb >> 11) * 2 + (c >> 6)) * 64 + (c & 63)) * S_ + (rb & 2047) + 4 * lh);
#pragma unroll
    for (int g4 = 0; g4 < 4; ++g4) {
      ushort4 o; o.x = f2bf(a[4 * g4]); o.y = f2bf(a[4 * g4 + 1]); o.z = f2bf(a[4 * g4 + 2]); o.w = f2bf(a[4 * g4 + 3]);
      *(ushort4*)(base + 8 * g4) = o;
    }
    return true;
  }
  DEV void operator()(int t, int n, float v) const {
    if (n < 512) q[(unsigned)(t * 512 + n)] = f2bf(v * (0.125f * 1.4426950408889634f));
    else if (n < 768) kvc[(unsigned)(t * 256 + (n - 512))] = f2bf(v);
    else if (n < 896) kslc[(unsigned)(t * 128 + (n - 768))] = f2bf(v);
    else if (n < 1024) { int c = n - 896; vslct[(unsigned)((((t >> 11) * 2 + (c >> 6)) * 64 + (c & 63)) * S_ + (t & 2047))] = f2bf(v); }
    else if (n < 1152) kwin[(unsigned)(t * 128 + (n - 1024))] = f2bf(v);
    else if (n < 1280) { int c = n - 1152; vwint[(unsigned)((((t >> 11) * 2 + (c >> 6)) * 64 + (c & 63)) * S_ + (t & 2047))] = f2bf(v); }
    else if (n < 1304) gate[(unsigned)(t * 24 + (n - 1280))] = sigm(v);
    else if (n < NZ) rw[(unsigned)(t * RWC + (n - 1304))] = f2bf(v);
  }
};

DEV void ph_ztail(const Params& p, const ZEpi& e, int wv) {
  if (wv != 0) return;
  const int lane = opaque_tid(wv) & 63, l31 = lane & 31, lh = lane >> 5;
  const bf16_t* HB = (const bf16_t*)(p.ws + OFF_HB); const bf16_t* WT = (const bf16_t*)(p.ws + W_IN) + (size_t)3072 * 1024;
  for (int rb = blockIdx.x; rb < T_ / 32; rb += gridDim.x) {
    const bf16_t* ap = HB + (size_t)(32 * rb + l31) * 1024 + 8 * lh; const bf16_t* bp = WT + (size_t)l31 * 1024 + 8 * lh;
    f32x16 acc;
#pragma unroll
    for (int r = 0; r < 16; ++r) acc[r] = 0.f;
#pragma unroll 8
    for (int ks = 0; ks < 64; ++ks) acc = __builtin_amdgcn_mfma_f32_32x32x16_bf16(*(const bf16x8*)(ap + 16 * ks), *(const bf16x8*)(bp + 16 * ks), acc, 0, 0, 0);
#pragma unroll
    for (int r = 0; r < 16; ++r) e(32 * rb + (r & 3) + 8 * (r >> 2) + 4 * lh, 3072 + l31, acc[r]);
  }
}

DEV void shift8(const uint4& cur, const uint4& prv, const float* mu, float (&o)[8]) {
  float c[8], q[8]; unpack8(cur, c); unpack8(prv, q);
#pragma unroll
  for (int j = 0; j < 8; ++j) o[j] = c[j] + mu[j] * (q[j] - c[j]);
}
DEV uint4 pack8f(const float (&f)[8]) {
  uint4 u;
  u.x = (unsigned)f2bf(f[0]) | ((unsigned)f2bf(f[1]) << 16); u.y = (unsigned)f2bf(f[2]) | ((unsigned)f2bf(f[3]) << 16);
  u.z = (unsigned)f2bf(f[4]) | ((unsigned)f2bf(f[5]) << 16); u.w = (unsigned)f2bf(f[6]) | ((unsigned)f2bf(f[7]) << 16);
  return u;
}
DEV float fast_tanh(float x) { const float e = __expf(2.f * x); return 1.f - 2.f / (e + 1.f); }

DEV void ph_prep2(const Params& p, unsigned char* lds, int wv) {
  const int tid = opaque_tid(wv), lane = tid & 63, w = tid >> 6, l31 = lane & 31, lh = lane >> 5;
  const bf16_t* RW = (const bf16_t*)p.out;
  bf16_t* R = (bf16_t*)(p.ws + OFF_R); bf16_t* OMD = (bf16_t*)(p.ws + OFF_OMD); bf16_t* KP = (bf16_t*)(p.ws + OFF_KP);
  bf16_t* V = (bf16_t*)(p.ws + OFF_V); bf16_t* KB = (bf16_t*)(p.ws + OFF_KB); bf16_t* G = (bf16_t*)(p.ws + OFF_G);
  const bf16_t* W2T = (const bf16_t*)(p.ws + W_LW); const bf16_t* A2T = (const bf16_t*)(p.ws + W_LA); const bf16_t* G2T = (const bf16_t*)(p.ws + W_LG);
  const float* mu = p.in[I_MU];
  float* inv = (float*)(lds + 16384);
  unsigned char* ksm = lds + 20480;
  const uint4 zero4 = make_uint4(0u, 0u, 0u, 0u);
  for (int item = blockIdx.x; item < T_ / 32; item += gridDim.x) {
    const int t0 = item * 32; const bool first = (t0 & 2047) == 0;
    __syncthreads();
    for (int idx = tid; idx < 1024; idx += 256) {
      const int row = idx >> 5, ch = idx & 31;
      const bf16_t* src = RW + (size_t)(t0 + row) * RWC + 1536 + ch * 8;
      const uint4 cur = *(const uint4*)src;
      const uint4 prv = (first && row == 0) ? zero4 : *(const uint4*)(src - RWC);
      float x[8]; shift8(cur, prv, mu + 1536 + ch * 8, x);
      if (ch < 8) {
#pragma unroll
        for (int j = 0; j < 8; ++j) x[j] = fast_tanh(x[j]);
      } else if (ch >= 16) {
#pragma unroll
        for (int j = 0; j < 8; ++j) x[j] = sigm(x[j]);
      }
      *(uint4*)(lds + row * 512 + ((ch ^ (row & 15)) << 4)) = pack8f(x);
    }
#pragma unroll 2
    for (int row = w; row < 32; row += 4) {
      const size_t t = t0 + row;
      const bool nopv = first && row == 0;
      const bf16_t* src = RW + t * RWC + lane * 8;
      const uint4 c0 = *(const uint4*)src, c1 = *(const uint4*)(src + 512), c2 = *(const uint4*)(src + 1024);
      const uint4 p0 = nopv ? zero4 : *(const uint4*)(src - RWC), p1 = nopv ? zero4 : *(const uint4*)(src + 512 - RWC), p2 = nopv ? zero4 : *(const uint4*)(src + 1024 - RWC);
      float x[8];
      shift8(c0, p0, mu + lane * 8, x);
      *(uint4*)(R + t * 512 + lane * 8) = pack8f(x);
      shift8(c2, p2, mu + 1024 + lane * 8, x);
      *(uint4*)(V + t * 512 + lane * 8) = pack8f(x);
      shift8(c1, p1, mu + 512 + lane * 8, x);
      const uint4 kq = pack8f(x);
      *(uint4*)(ksm + row * 1024 + lane * 16) = kq;
      float kr[8]; unpack8(kq, kr);
      float ss = 0.f;
#pragma unroll
      for (int j = 0; j < 8; ++j) { const float q = kr[j] * p.in[I_KK][lane * 8 + j]; ss += q * q; }
      ss = sum8lanes(ss);
      if ((lane & 7) == 0) inv[row * 8 + (lane >> 3)] = 1.f / fmaxf(sqrtf(ss), 1e-12f);
    }
    asm volatile("s_waitcnt vmcnt(0)" ::: "memory");
    __syncthreads();
    {
      constexpr int mb = 0;
      const int arow = l31;
#pragma unroll 1
      for (int nb = 0; nb < 4; ++nb) {
        const int n = 128 * w + 32 * nb + l31;
        {
          f32x16 acc;
#pragma unroll
          for (int r = 0; r < 16; ++r) acc[r] = 0.f;
#pragma unroll
          for (int s = 0; s < 4; ++s) {
            const bf16x8 af = *(const bf16x8*)(lds + arow * 512 + (((2 * s + lh) ^ (arow & 15)) << 4));
            const bf16x8 bfr = *(const bf16x8*)(W2T + (size_t)n * 64 + 16 * s + 8 * lh);
            acc = __builtin_amdgcn_mfma_f32_32x32x16_bf16(af, bfr, acc, 0, 0, 0);
          }
          const float w0 = p.in[I_W0][n];
#pragma unroll
          for (int r = 0; r < 16; ++r) {
            const size_t t = t0 + 32 * mb + (r & 3) + 8 * (r >> 2) + 4 * lh;
            const float nx = -(w0 + acc[r]);
            const float sp = fmaxf(nx, 0.f) + __logf(1.f + __expf(-fabsf(nx)));
            const float e = __expf(-sp - 0.5f);
            OMD[t * 512 + n] = f2bf(1.f - __expf(-e));
          }
        }
        {
          f32x16 acc;
#pragma unroll
          for (int r = 0; r < 16; ++r) acc[r] = 0.f;
#pragma unroll
          for (int s = 0; s < 4; ++s) {
            const bf16x8 af = *(const bf16x8*)(lds + arow * 512 + (((8 + 2 * s + lh) ^ (arow & 15)) << 4));
            const bf16x8 bfr = *(const bf16x8*)(A2T + (size_t)n * 64 + 16 * s + 8 * lh);
            acc = __builtin_amdgcn_mfma_f32_32x32x16_bf16(af, bfr, acc, 0, 0, 0);
          }
          const int h = n >> 6, c = n & 63;
          const float a0 = p.in[I_A0][n], kkw = p.in[I_KK][n], kaw = p.in[I_KA][n];
#pragma unroll
          for (int r = 0; r < 16; ++r) {
            const int lrow = 32 * mb + (r & 3) + 8 * (r >> 2) + 4 * lh;
            const size_t t = t0 + lrow;
            const float a = sigm(a0 + acc[r]);
            const float k = bf2f(*(const bf16_t*)(ksm + lrow * 1024 + n * 2));
            const float kk = k * kkw * inv[lrow * 8 + h];
            KP[t * 512 + n] = f2bf(k * (1.f + (a - 1.f) * kaw));
            KB[(t * 8 + h) * 128 + c] = f2bf(kk);
            KB[(t * 8 + h) * 128 + 64 + c] = f2bf(kk * a);
          }
        }
        {
          f32x16 acc;
#pragma unroll
          for (int r = 0; r < 16; ++r) acc[r] = 0.f;
#pragma unroll
          for (int s = 0; s < 8; ++s) {
            const bf16x8 af = *(const bf16x8*)(lds + arow * 512 + (((16 + 2 * s + lh) ^ (arow & 15)) << 4));
            const bf16x8 bfr = *(const bf16x8*)(G2T + (size_t)n * 128 + 16 * s + 8 * lh);
            acc = __builtin_amdgcn_mfma_f32_32x32x16_bf16(af, bfr, acc, 0, 0, 0);
          }
#pragma unroll
          for (int r = 0; r < 16; ++r) {
            const size_t t = t0 + 32 * mb + (r & 3) + 8 * (r >> 2) + 4 * lh;
            G[t * 512 + n] = f2bf(acc[r]);
          }
        }
      }
    }
  }
}

DEV int swz32(int row, int c) { return row * 64 + ((c ^ ((row >> 2) & 3)) << 4); }
DEV void ph_cmp2(const Params& p, unsigned char* lds, int wv) {
  const int tid = opaque_tid(wv), lane = tid & 63, l31 = lane & 31, lh = lane >> 5;
  const bf16_t* kvc = (const bf16_t*)(p.ws + OFF_KVC);
  bf16_t* KC = (bf16_t*)(p.ws + OFF_KC); bf16_t* VCT = (bf16_t*)(p.ws + OFF_VCT);
  const float* C1 = (const float*)(p.ws + W_C1);
  for (int item = blockIdx.x; item < 128; item += gridDim.x) {
    const int kv = item >> 6, m0 = (item & 63) * 32;
    const bf16_t* W1T = (const bf16_t*)(p.ws + W_C1T) + (size_t)kv * 256 * 2048;
    const bf16_t* W2T = (const bf16_t*)(p.ws + W_C2T) + (size_t)kv * 64 * 256;
    const int am = m0 + l31, abg = am >> 7, ac = am & 127;
    const bf16_t* ap = kvc + ((size_t)(abg >> 1) * S_ + 16 * ac) * 256 + kv * 128 + (abg & 1) * 64 + 8 * lh;
    const bf16_t* bp0 = W1T + (size_t)(lh * 256 + 64 * wv + l31) * 8;
    const bf16_t* bp1 = bp0 + 32 * 8;
    f32x16 acc[2];
#pragma unroll
    for (int r = 0; r < 16; ++r) { acc[0][r] = 0.f; acc[1][r] = 0.f; }
#pragma unroll 8
    for (int ks = 0; ks < 128; ++ks) {
      const bf16x8 af = *(const bf16x8*)(ap + (ks >> 2) * 256 + (ks & 3) * 16);
      const bf16x8 b0 = *(const bf16x8*)(bp0 + (size_t)ks * (2 * 256 * 8));
      const bf16x8 b1 = *(const bf16x8*)(bp1 + (size_t)ks * (2 * 256 * 8));
      acc[0] = __builtin_amdgcn_mfma_f32_32x32x16_bf16(af, b0, acc[0], 0, 0, 0);
      acc[1] = __builtin_amdgcn_mfma_f32_32x32x16_bf16(af, b1, acc[1], 0, 0, 0);
    }
    __syncthreads();
#pragma unroll
    for (int nb = 0; nb < 2; ++nb) {
      const int n = 64 * wv + 32 * nb + l31;
      const float c1 = C1[kv * 256 + n];
#pragma unroll
      for (int r = 0; r < 16; ++r) {
        const int row = (r & 3) + 8 * (r >> 2) + 4 * lh;
        *(bf16_t*)(lds + row * 512 + (((n >> 3) ^ (row & 15)) << 4) + (n & 7) * 2) = f2bf(gelu_tanh(acc[nb][r] + c1));
      }
    }
    __syncthreads();
    if (wv < 2) {
      f32x16 o;
#pragma unroll
      for (int r = 0; r < 16; ++r) o[r] = 0.f;
#pragma unroll
      for (int s = 0; s < 16; ++s) {
        const bf16x8 af = *(const bf16x8*)(lds + l31 * 512 + (((2 * s + lh) ^ (l31 & 15)) << 4));
        const bf16x8 bfr = *(const bf16x8*)(W2T + (size_t)(32 * wv + l31) * 256 + 16 * s + 8 * lh);
        o = __builtin_amdgcn_mfma_f32_32x32x16_bf16(af, bfr, o, 0, 0, 0);
      }
      const int n = 32 * wv + l31;
      const float b2 = p.in[I_CB2][kv * 64 + n];
      if (kv == 0) {
#pragma unroll
        for (int r = 0; r < 16; ++r) { const int m = m0 + (r & 3) + 8 * (r >> 2) + 4 * lh; KC[(size_t)m * 64 + n] = f2bf(o[r] + b2); }
      } else {
#pragma unroll
        for (int g4 = 0; g4 < 4; ++g4) {
          const int m = m0 + 8 * g4 + 4 * lh, bg = m >> 7, c = m & 127;
          ushort4 q; q.x = f2bf(o[4 * g4] + b2); q.y = f2bf(o[4 * g4 + 1] + b2); q.z = f2bf(o[4 * g4 + 2] + b2); q.w = f2bf(o[4 * g4 + 3] + b2);
          *(ushort4*)(VCT + ((size_t)bg * 64 + n) * 128 + c) = q;
        }
      }
    }
  }
}

DEV float dpp_row_sum16(float x) {
  x += __int_as_float(__builtin_amdgcn_update_dpp(0, __float_as_int(x), 0xB1, 0xF, 0xF, true));
  x += __int_as_float(__builtin_amdgcn_update_dpp(0, __float_as_int(x), 0x4E, 0xF, 0xF, true));
  x += __int_as_float(__builtin_amdgcn_update_dpp(0, __float_as_int(x), 0x124, 0xF, 0xF, true));
  x += __int_as_float(__builtin_amdgcn_update_dpp(0, __float_as_int(x), 0x128, 0xF, 0xF, true));
  return x;
}

DEV void ph_scan2(const Params& p, float* lds, int wv) {
  const int tid = opaque_tid(wv);
  const bf16_t* R = (const bf16_t*)(p.ws + OFF_R); const bf16_t* OMD = (const bf16_t*)(p.ws + OFF_OMD); const bf16_t* KP = (const bf16_t*)(p.ws + OFF_KP);
  const bf16_t* V = (const bf16_t*)(p.ws + OFF_V); const bf16_t* KB = (const bf16_t*)(p.ws + OFF_KB);
  bf16_t* Y = (bf16_t*)(p.ws + OFF_Y);
  constexpr int CH = 16;
  const int kpart = tid & 15, rp = tid >> 4, k0 = kpart * 4;
  const int li = tid >> 4, lc4 = (tid & 15) * 4;
  __builtin_amdgcn_s_setprio(3);
  for (int item = blockIdx.x; item < 256; item += gridDim.x) {
    const int bh = item >> 2, vq = item & 3, b = bh >> 3, h = bh & 7;
    const int row0 = vq * 16 + rp;
    float s0 = 0.f, s1 = 0.f, s2 = 0.f, s3 = 0.f;
    ushort4 g0, g1, g2, g3, g4, g5;
#define SC_GLOAD(c0_) do { const size_t t_ = (size_t)b * S_ + (c0_) + li; const size_t o_ = t_ * 512 + h * 64 + lc4; const size_t ob_ = (t_ * 8 + h) * 128 + lc4; \
      g0 = *(const ushort4*)(R + o_); g1 = *(const ushort4*)(OMD + o_); g2 = *(const ushort4*)(KP + o_); g3 = *(const ushort4*)(V + o_); \
      g4 = *(const ushort4*)(KB + ob_); g5 = *(const ushort4*)(KB + ob_ + 64); } while (0)
#define SC_LSTORE(buf_) do { float* d_ = lds + (buf_) * (CH * 384) + li * 384 + lc4; \
      *(float4*)(d_) = make_float4(bf2f(g0.x), bf2f(g0.y), bf2f(g0.z), bf2f(g0.w)); \
      *(float4*)(d_ + 64) = make_float4(1.f - bf2f(g1.x), 1.f - bf2f(g1.y), 1.f - bf2f(g1.z), 1.f - bf2f(g1.w)); \
      *(float4*)(d_ + 128) = make_float4(bf2f(g2.x), bf2f(g2.y), bf2f(g2.z), bf2f(g2.w)); \
      *(float4*)(d_ + 192) = make_float4(bf2f(g3.x), bf2f(g3.y), bf2f(g3.z), bf2f(g3.w)); \
      *(float4*)(d_ + 256) = make_float4(bf2f(g4.x), bf2f(g4.y), bf2f(g4.z), bf2f(g4.w)); \
      *(float4*)(d_ + 320) = make_float4(bf2f(g5.x), bf2f(g5.y), bf2f(g5.z), bf2f(g5.w)); } while (0)
    __syncthreads();
    SC_GLOAD(0); SC_LSTORE(0);
    __syncthreads();
    for (int c = 0; c < S_ / CH; ++c) {
      if (c + 1 < S_ / CH) SC_GLOAD((c + 1) * CH);
      const float* base = lds + (c & 1) * (CH * 384);
      float yk[CH];
      float4 o_r[3], o_d[3], o_k[3], o_q[3], o_b[3]; float o_v[3];
#define SC_LD(slot_, i_) do { const float* tk_ = base + (i_) * 384; o_r[slot_] = *(const float4*)(tk_ + k0); o_d[slot_] = *(const float4*)(tk_ + 64 + k0); \
        o_k[slot_] = *(const float4*)(tk_ + 128 + k0); o_q[slot_] = *(const float4*)(tk_ + 256 + k0); o_b[slot_] = *(const float4*)(tk_ + 320 + k0); o_v[slot_] = tk_[192 + row0]; } while (0)
      SC_LD(0, 0); SC_LD(1, 1);
#pragma unroll
      for (int i = 0; i < CH; ++i) {
        if (i + 2 < CH) SC_LD((i + 2) % 3, i + 2);
        const float4 rr = o_r[i % 3], dd = o_d[i % 3], kp = o_k[i % 3], kk = o_q[i % 3], bb = o_b[i % 3];
        const float vv = o_v[i % 3];
        float sa = (s0 * kk.x + s1 * kk.y) + (s2 * kk.z + s3 * kk.w);
        sa = -dpp_row_sum16(sa);
        s0 = s0 * dd.x + sa * bb.x + vv * kp.x; s1 = s1 * dd.y + sa * bb.y + vv * kp.y; s2 = s2 * dd.z + sa * bb.z + vv * kp.z; s3 = s3 * dd.w + sa * bb.w + vv * kp.w;
        yk[i] = s0 * rr.x + s1 * rr.y + s2 * rr.z + s3 * rr.w;
      }
#pragma unroll
      for (int i = 0; i < 8; ++i) { const bool up = kpart & 8; const float keep = up ? yk[i + 8] : yk[i]; const float send = up ? yk[i] : yk[i + 8];
        yk[i] = keep + __int_as_float(__builtin_amdgcn_update_dpp(0, __float_as_int(send), 0x128, 0xF, 0xF, true)); }
#pragma unroll
      for (int i = 0; i < 4; ++i) { const bool up = kpart & 4; const float keep = up ? yk[i + 4] : yk[i]; const float send = up ? yk[i] : yk[i + 4];
        yk[i] = keep + SWZ_XOR(send, 4); }
#pragma unroll
      for (int i = 0; i < 2; ++i) { const bool up = kpart & 2; const float keep = up ? yk[i + 2] : yk[i]; const float send = up ? yk[i] : yk[i + 2];
        yk[i] = keep + __int_as_float(__builtin_amdgcn_update_dpp(0, __float_as_int(send), 0x4E, 0xF, 0xF, true)); }
      { const bool up = kpart & 1; const float keep = up ? yk[1] : yk[0]; const float send = up ? yk[0] : yk[1];
        yk[0] = keep + __int_as_float(__builtin_amdgcn_update_dpp(0, __float_as_int(send), 0xB1, 0xF, 0xF, true)); }
      {
        const size_t t = (size_t)b * S_ + c * CH + kpart;
        Y[(t * 8 + h) * 64 + row0] = f2bf(yk[0]);
      }
      if (c + 1 < S_ / CH) SC_LSTORE((c + 1) & 1);
      __syncthreads();
    }
  }
  __builtin_amdgcn_s_setprio(0);
}

typedef __attribute__((ext_vector_type(4))) short s16x4;
constexpr float LOG2E = 1.4426950408889634f;

DEV bf16x8 pack8(const f32x16& x, int s) {
  u32x4 q;
  if (s == 0)
    asm volatile("v_cvt_pk_bf16_f32 %0, %4, %5\n\tv_cvt_pk_bf16_f32 %1, %6, %7\n\tv_cvt_pk_bf16_f32 %2, %8, %9\n\tv_cvt_pk_bf16_f32 %3, %10, %11\n\ts_nop 1"
                 : "=&v"(q[0]), "=&v"(q[1]), "=&v"(q[2]), "=&v"(q[3])
                 : "v"(x[0]), "v"(x[1]), "v"(x[2]), "v"(x[3]), "v"(x[4]), "v"(x[5]), "v"(x[6]), "v"(x[7]));
  else
    asm volatile("v_cvt_pk_bf16_f32 %0, %4, %5\n\tv_cvt_pk_bf16_f32 %1, %6, %7\n\tv_cvt_pk_bf16_f32 %2, %8, %9\n\tv_cvt_pk_bf16_f32 %3, %10, %11\n\ts_nop 1"
                 : "=&v"(q[0]), "=&v"(q[1]), "=&v"(q[2]), "=&v"(q[3])
                 : "v"(x[8]), "v"(x[9]), "v"(x[10]), "v"(x[11]), "v"(x[12]), "v"(x[13]), "v"(x[14]), "v"(x[15]));
  return __builtin_bit_cast(bf16x8, q);
}

DEV int vswz(int d, int chunk, int half) { return d * 128 + ((chunk ^ ((d >> 1) & 7)) << 4) + ((half ^ ((d >> 4) & 1)) << 3); }


DEV void ph_nsa_mfma(const Params& p, unsigned char* lds, unsigned* ctr, int wv) {
  const bf16_t* Q = (const bf16_t*)(p.ws + OFF_Q);
  const bf16_t* KC = (const bf16_t*)(p.ws + OFF_KC); const bf16_t* VCT = (const bf16_t*)(p.ws + OFF_VCT);
  const bf16_t* KSLC = (const bf16_t*)(p.ws + OFF_KSLC); const bf16_t* KWIN = (const bf16_t*)(p.ws + OFF_KWIN);
  const bf16_t* VSLCT = (const bf16_t*)(p.ws + OFF_VSLCT); const bf16_t* VWINT = (const bf16_t*)(p.ws + OFF_VWINT);
  const float* GATE = (const float*)(p.ws + OFF_GATE);
  bf16_t* YN = (bf16_t*)(p.ws + OFF_YNSA);
  unsigned char* Kl = lds;
  unsigned char* Vl = lds + 16384;
  float* tb = (float*)(lds + 32768);
  float* impP = (float*)(lds + 34816);
  float* scl = (float*)(lds + 34816 + 16896);
  unsigned* selm = (unsigned*)(lds + 34816 + 16896 + 4224);
  int* sitem = (int*)(lds + 34816 + 16896 + 4224 + 128);
  const int NITEMS = B_ * 2 * 64;
  for (;;) {
    __syncthreads();
    if (opaque_tid(wv) == 0) sitem[0] = (int)atomicAdd(ctr, 1u);
    __syncthreads();
    const int item = sitem[0];
    if (item >= NITEMS) break;
    const int tid = opaque_tid(wv);
    const int lane = tid & 63, hp = tid >> 6, l31 = lane & 31, lh = lane >> 5;
    const int qb = 63 - (item >> 4), g = item & 1, b = (item >> 1) & 7;
    const int bg = b * 2 + g, head = g * 4 + hp;
    const int s0 = qb * 32, cur = s0 >> 6;
    const int sq = s0 + l31;
    const size_t tq = (size_t)b * S_ + sq;
    for (int e = tid; e < 512; e += 256) { int hh = e >> 7, d = e & 127; tb[e] = p.in[I_RELB][T5B[d] * 8 + g * 4 + hh] * LOG2E; }
    bf16x8 qf[4];
#pragma unroll
    for (int s = 0; s < 4; ++s) qf[s] = *(const bf16x8*)(Q + tq * 512 + head * 64 + 16 * s + 8 * lh);
    const float* mytb = tb + hp * 128;
    const int nct = (qb <= 31) ? 1 : 2;
    int wlo = s0 - 511; if (wlo < 0) wlo = 0;
    const int ktlo = wlo >> 6;
    const int nslc = cur + 1, nwin = cur - ktlo + 1;
    const int NT = 2 * nct + nslc + nwin;
#define GET_TILE(ti_, kp_, vp_, ks_, vs_, md_, p0_) do { \
      const int ti__ = (ti_); \
      if (ti__ < 2 * nct) { \
        const int c0 = (ti__ < nct ? ti__ : ti__ - nct) * 64; \
        kp_ = KC + ((size_t)bg * 128 + c0) * 64; ks_ = 64; vp_ = VCT + (size_t)bg * 64 * 128 + c0; vs_ = 128; md_ = ti__ < nct ? 0 : 1; p0_ = c0; \
      } else if (ti__ < 2 * nct + nslc) { \
        const int k0 = (ti__ - 2 * nct) * 64; \
        kp_ = KSLC + ((size_t)b * S_ + k0) * 128 + g * 64; ks_ = 128; vp_ = VSLCT + (size_t)bg * 64 * S_ + k0; vs_ = S_; md_ = 2; p0_ = k0; \
      } else { \
        const int k0 = (ktlo + ti__ - 2 * nct - nslc) * 64; \
        kp_ = KWIN + ((size_t)b * S_ + k0) * 128 + g * 64; ks_ = 128; vp_ = VWINT + (size_t)bg * 64 * S_ + k0; vs_ = S_; md_ = 3; p0_ = k0; \
      } } while (0)
    uint4 rk0, rk1, rv0, rv1;
    const int srow0 = tid >> 3, srow1 = (tid + 256) >> 3, sc = tid & 7;
#define NSA_GLOAD(kp, vp, kstride, vstride) do { \
      rk0 = *(const uint4*)((kp) + (size_t)srow0 * (kstride) + sc * 8); rk1 = *(const uint4*)((kp) + (size_t)srow1 * (kstride) + sc * 8); \
      rv0 = *(const uint4*)((vp) + (size_t)srow0 * (vstride) + sc * 8); rv1 = *(const uint4*)((vp) + (size_t)srow1 * (vstride) + sc * 8); } while (0)
#define NSA_LSTORE(buf) do { \
      *(uint4*)(Kl + (buf) * 8192 + swz(srow0, sc)) = rk0; *(uint4*)(Kl + (buf) * 8192 + swz(srow1, sc)) = rk1; \
      { uint4 v = rv0; if ((srow0 >> 4) & 1) { unsigned tx = v.x, ty = v.y; v.x = v.z; v.y = v.w; v.z = tx; v.w = ty; } \
        *(uint4*)(Vl + (buf) * 8192 + srow0 * 128 + ((sc ^ ((srow0 >> 1) & 7)) << 4)) = v; } \
      { uint4 v = rv1; if ((srow1 >> 4) & 1) { unsigned tx = v.x, ty = v.y; v.x = v.z; v.y = v.w; v.z = tx; v.w = ty; } \
        *(uint4*)(Vl + (buf) * 8192 + srow1 * 128 + ((sc ^ ((srow1 >> 1) & 7)) << 4)) = v; } } while (0)
    f32x16 O[2]; unsigned OUTP[2][8];
#pragma unroll
    for (int r = 0; r < 16; ++r) { O[0][r] = 0.f; O[1][r] = 0.f; }
#pragma unroll
    for (int r = 0; r < 8; ++r) { OUTP[0][r] = 0u; OUTP[1][r] = 0u; }
    float m = NEGF, l = 0.f;
    float invl_cmp = 0.f, m_cmpe = 0.f;
    float carry_prev = 0.f;
    unsigned mymask = 0u;
    const bf16_t *kpn, *vpn; int ksn, vsn, mode, pos0, moden, pos0n;
    GET_TILE(0, kpn, vpn, ksn, vsn, mode, pos0);
    NSA_GLOAD(kpn, vpn, ksn, vsn); NSA_LSTORE(0);
    __syncthreads();
    for (int ti = 0; ti < NT; ++ti) {
      moden = mode; pos0n = pos0;
      if (ti + 1 < NT) { GET_TILE(ti + 1, kpn, vpn, ksn, vsn, moden, pos0n); NSA_GLOAD(kpn, vpn, ksn, vsn); }
      if (ti == nct) {
        const float g0 = GATE[tq * 24 + head * 3];
        const float il = l > 0.f ? 1.f / l : 0.f;
#pragma unroll
        for (int r = 0; r < 8; ++r) {
          OUTP[0][r] = (unsigned)f2bf(g0 * il * O[0][2 * r]) | ((unsigned)f2bf(g0 * il * O[0][2 * r + 1]) << 16);
          OUTP[1][r] = (unsigned)f2bf(g0 * il * O[1][2 * r]) | ((unsigned)f2bf(g0 * il * O[1][2 * r + 1]) << 16);
        }
#pragma unroll
        for (int r = 0; r < 16; ++r) { O[0][r] = 0.f; O[1][r] = 0.f; }
        invl_cmp = il; m_cmpe = (m < -1e29f) ? 0.f : m; carry_prev = 0.f;
      }
      if (ti == 2 * nct) {
        __syncthreads();
        {
          const int q = tid >> 3, jb = (tid & 7) * 4;
#pragma unroll
          for (int jj = 0; jj < 4; ++jj) {
            const int j = jb + jj;
            float imp = impP[(0 * 32 + q) * 33 + j] + impP[(1 * 32 + q) * 33 + j] + impP[(2 * 32 + q) * 33 + j] + impP[(3 * 32 + q) * 33 + j];
            const bool forced = (j == 0) || (j == cur) || (j == cur - 1);
            scl[q * 33 + j] = (j > cur) ? NEGF : imp + (forced ? 1.0e4f : 0.f);
          }
          if (tid < 32) selm[tid] = 0u;
        }
        __syncthreads();
        {
          const int q = tid >> 3, jb = (tid & 7) * 4;
          unsigned bits = 0u;
#pragma unroll
          for (int jj = 0; jj < 4; ++jj) {
            const int j = jb + jj;
            const float sj = scl[q * 33 + j]; int rank = 0;
#pragma unroll 1
            for (int i = 0; i < 32; ++i) { const float si = scl[q * 33 + i]; rank += (si > sj || (si == sj && i < j)) ? 1 : 0; }
            if (rank < 16 && j <= cur) bits |= 1u << j;
          }
          if (bits) atomicOr(&selm[q], bits);
        }
        __syncthreads();
        mymask = selm[l31];
        m = NEGF; l = 0.f;
      }
      if (ti == 2 * nct + nslc) {
        const float g1 = GATE[tq * 24 + head * 3 + 1];
        const float il = l > 0.f ? 1.f / l : 0.f;
#pragma unroll
        for (int r = 0; r < 8; ++r) {
#pragma unroll
          for (int db = 0; db < 2; ++db) {
            const float lo = __uint_as_float(OUTP[db][r] << 16) + g1 * il * O[db][2 * r], hi = __uint_as_float(OUTP[db][r] & 0xffff0000u) + g1 * il * O[db][2 * r + 1];
            OUTP[db][r] = (unsigned)f2bf(lo) | ((unsigned)f2bf(hi) << 16);
          }
        }
#pragma unroll
        for (int r = 0; r < 16; ++r) { O[0][r] = 0.f; O[1][r] = 0.f; }
        m = NEGF; l = 0.f;
      }
      const unsigned char* kb_ = Kl + (ti & 1) * 8192; const unsigned char* vb_ = Vl + (ti & 1) * 8192;
      f32x16 S[2];
#pragma unroll
      for (int r = 0; r < 16; ++r) { S[0][r] = 0.f; S[1][r] = 0.f; }
#pragma unroll
      for (int s = 0; s < 4; ++s) {
        bf16x8 k0 = *(const bf16x8*)(kb_ + swz(l31, 2 * s + lh));
        bf16x8 k1 = *(const bf16x8*)(kb_ + swz(32 + l31, 2 * s + lh));
        S[0] = __builtin_amdgcn_mfma_f32_32x32x16_bf16(k0, qf[s], S[0], 0, 0, 0);
        S[1] = __builtin_amdgcn_mfma_f32_32x32x16_bf16(k1, qf[s], S[1], 0, 0, 0);
      }
      __builtin_amdgcn_sched_barrier(0);
      const int kmul = (mode < 2) ? 16 : 1;
      const int d0 = ((mode < 2) ? (sq - 31 - 16 * pos0) : (sq - pos0)) - kmul * 4 * lh;
      const unsigned selbit = (mode == 2) ? ((mymask >> (pos0 >> 6)) & 1u) : 1u;
      const unsigned dmaxl = selbit ? ((mode == 3) ? 512u : 0x7fffffffu) : 0u;
      float mx = NEGF;
      const int dmin = ((mode < 2) ? (s0 - 31 - 16 * (pos0 + 63)) : (s0 - (pos0 + 63)));
      const int dmaxt = ((mode < 2) ? (s0 + 31 - 31 - 16 * pos0) : (s0 + 31 - pos0));
      const bool fast = (dmin >= 113) && (mode != 3 || dmaxt < 512);
      if (fast) {
        const float cb = mytb[127];
        const bool on = dmaxl != 0u;
#pragma unroll
        for (int kb = 0; kb < 2; ++kb)
#pragma unroll
          for (int r = 0; r < 16; ++r) { const float v = on ? S[kb][r] + cb : NEGF; S[kb][r] = v; mx = fmaxf(mx, v); }
      } else {
#pragma unroll
      for (int kb = 0; kb < 2; ++kb)
#pragma unroll
        for (int r = 0; r < 16; ++r) {
          const int koff = 32 * kb + (r & 3) + 8 * (r >> 2);
          const unsigned dist = (unsigned)(d0 - kmul * koff);
          const unsigned di = dist < 127u ? dist : 127u;
          float bias = mytb[di];
          asm volatile("" : "+v"(bias));
          const float v = (dist < dmaxl) ? S[kb][r] + bias : NEGF;
          S[kb][r] = v;
          mx = fmaxf(mx, v);
        }
      }
      mx = xor32_max(mx);
      if (mode == 1) {
        float lastother = carry_prev;
#pragma unroll
        for (int kb = 0; kb < 2; ++kb)
#pragma unroll
          for (int g4 = 0; g4 < 4; ++g4) {
            float pr[4];
#pragma unroll
            for (int i = 0; i < 4; ++i) pr[i] = __builtin_amdgcn_exp2f(S[kb][g4 * 4 + i] - m_cmpe) * invl_cmp;
            const float own = pr[0] + pr[1] + pr[2] + 0.5f * pr[3];
            const float cr = 0.5f * pr[3];
            const float other = __uint_as_float(xor32_get(__float_as_uint(cr), lh));
            const float tot = own + (lh ? other : lastother);
            lastother = other;
            const int j = (pos0 >> 2) + 8 * kb + 2 * g4 + lh;
            impP[(hp * 32 + l31) * 33 + j] = tot;
          }
        carry_prev = lastother;
      } else {
        const float mn = fmaxf(m, mx);
        const float alpha = __builtin_amdgcn_exp2f(m - mn);
        const float mne = (mn < -1e29f) ? 0.f : mn;
        float rs = 0.f;
#pragma unroll
        for (int kb = 0; kb < 2; ++kb)
#pragma unroll
          for (int r = 0; r < 16; ++r) { const float pr = __builtin_amdgcn_exp2f(S[kb][r] - mne); S[kb][r] = pr; rs += pr; }
        rs = xor32_sum(rs);
        l = l * alpha + rs; m = mn;
#pragma unroll
        for (int r = 0; r < 16; ++r) { O[0][r] *= alpha; O[1][r] *= alpha; }
        __builtin_amdgcn_sched_barrier(0);
#pragma unroll
        for (int kb = 0; kb < 2; ++kb)
#pragma unroll
          for (int s2 = 0; s2 < 2; ++s2) {
            const bf16x8 pk = pack8(S[kb], s2);
            const int ch = 4 * kb + 2 * s2;
#pragma unroll
            for (int db = 0; db < 2; ++db) {
              const int d = 32 * db + l31;
              s16x4 lo = *(const s16x4*)(vb_ + vswz(d, ch, lh));
              s16x4 hi = *(const s16x4*)(vb_ + vswz(d, ch + 1, lh));
              const bf16x8 vf = __builtin_shufflevector(lo, hi, 0, 1, 2, 3, 4, 5, 6, 7);
              O[db] = __builtin_amdgcn_mfma_f32_32x32x16_bf16(vf, pk, O[db], 0, 0, 0);
            }
          }
      }
      if (ti + 1 < NT) NSA_LSTORE((ti + 1) & 1);
      __syncthreads();
      mode = moden; pos0 = pos0n;
    }
    {
      const float g2 = GATE[tq * 24 + head * 3 + 2];
      const float il = l > 0.f ? 1.f / l : 0.f;
#pragma unroll
      for (int db = 0; db < 2; ++db)
#pragma unroll
        for (int g4 = 0; g4 < 4; ++g4) {
          ushort4 o;
          o.x = f2bf(__uint_as_float(OUTP[db][g4 * 2] << 16) + g2 * il * O[db][g4 * 4 + 0]);
          o.y = f2bf(__uint_as_float(OUTP[db][g4 * 2] & 0xffff0000u) + g2 * il * O[db][g4 * 4 + 1]);
          o.z = f2bf(__uint_as_float(OUTP[db][g4 * 2 + 1] << 16) + g2 * il * O[db][g4 * 4 + 2]);
          o.w = f2bf(__uint_as_float(OUTP[db][g4 * 2 + 1] & 0xffff0000u) + g2 * il * O[db][g4 * 4 + 3]);
          *(ushort4*)(YN + tq * 512 + head * 64 + 32 * db + 8 * g4 + 4 * lh) = o;
        }
    }
  }
}

typedef __attribute__((ext_vector_type(2))) float f32x2;
DEV void ph_conv_tables8(const Params& p, int wv) {
  const int tid_ = opaque_tid(wv);
  const int lane = tid_ & 63;
  const int wg = blockIdx.x * 4 + (tid_ >> 6), nw = gridDim.x * 4;
  for (int rr = wg; rr < 2 * 16384; rr += nw) {
    const int tb = rr >> 14, row = rr & 16383;
    const float* src = (tb ? p.in[I_PV] : p.in[I_PU]) + (size_t)row * 1024 + lane * 16;
    float x[16];
#pragma unroll
    for (int i = 0; i < 4; ++i) { const float4 v = ((const float4*)src)[i]; x[4 * i] = v.x; x[4 * i + 1] = v.y; x[4 * i + 2] = v.z; x[4 * i + 3] = v.w; }
    float mx = 0.f;
#pragma unroll
    for (int i = 0; i < 16; ++i) mx = fmaxf(mx, fabsf(x[i]));
    mx = wave_max(mx);
    const float sc = mx > 0.f ? 240.f / mx : 0.f;
    unsigned w[4];
#pragma unroll
    for (int i = 0; i < 4; ++i) {
      int q = __builtin_amdgcn_cvt_pk_fp8_f32(x[4 * i] * sc, x[4 * i + 1] * sc, 0, false);
      q = __builtin_amdgcn_cvt_pk_fp8_f32(x[4 * i + 2] * sc, x[4 * i + 3] * sc, q, true);
      w[i] = (unsigned)q;
    }
    unsigned char* dst = p.ws + (tb ? OFF_V8 : OFF_U8) + (size_t)row * 1024 + lane * 16;
    *(uint4*)dst = make_uint4(w[0], w[1], w[2], w[3]);
    if (lane == 0) ((float*)(p.ws + OFF_SC8))[rr] = mx * (1.f / 240.f);
  }
}

DEV float dot16f8(const uint4& r, const float (&x)[16]) {
  f32x2 a;
  float s;
  a = __builtin_amdgcn_cvt_pk_f32_fp8((int)r.x, false); s = a.x * x[0] + a.y * x[1];
  a = __builtin_amdgcn_cvt_pk_f32_fp8((int)r.x, true);  s += a.x * x[2] + a.y * x[3];
  a = __builtin_amdgcn_cvt_pk_f32_fp8((int)r.y, false); s += a.x * x[4] + a.y * x[5];
  a = __builtin_amdgcn_cvt_pk_f32_fp8((int)r.y, true);  s += a.x * x[6] + a.y * x[7];
  a = __builtin_amdgcn_cvt_pk_f32_fp8((int)r.z, false); s += a.x * x[8] + a.y * x[9];
  a = __builtin_amdgcn_cvt_pk_f32_fp8((int)r.z, true);  s += a.x * x[10] + a.y * x[11];
  a = __builtin_amdgcn_cvt_pk_f32_fp8((int)r.w, false); s += a.x * x[12] + a.y * x[13];
  a = __builtin_amdgcn_cvt_pk_f32_fp8((int)r.w, true);  s += a.x * x[14] + a.y * x[15];
  return s;
}
DEV void axpy16f8(const uint4& r, float w, float (&acc)[16]) {
  f32x2 a;
  a = __builtin_amdgcn_cvt_pk_f32_fp8((int)r.x, false); acc[0] += w * a.x; acc[1] += w * a.y;
  a = __builtin_amdgcn_cvt_pk_f32_fp8((int)r.x, true);  acc[2] += w * a.x; acc[3] += w * a.y;
  a = __builtin_amdgcn_cvt_pk_f32_fp8((int)r.y, false); acc[4] += w * a.x; acc[5] += w * a.y;
  a = __builtin_amdgcn_cvt_pk_f32_fp8((int)r.y, true);  acc[6] += w * a.x; acc[7] += w * a.y;
  a = __builtin_amdgcn_cvt_pk_f32_fp8((int)r.z, false); acc[8] += w * a.x; acc[9] += w * a.y;
  a = __builtin_amdgcn_cvt_pk_f32_fp8((int)r.z, true);  acc[10] += w * a.x; acc[11] += w * a.y;
  a = __builtin_amdgcn_cvt_pk_f32_fp8((int)r.w, false); acc[12] += w * a.x; acc[13] += w * a.y;
  a = __builtin_amdgcn_cvt_pk_f32_fp8((int)r.w, true);  acc[14] += w * a.x; acc[15] += w * a.y;
}

DEV void ph_peer_gather3(const Params& p, int dummy, int wv) {
  const int tid_ = opaque_tid(wv);
  const int lane = tid_ & 63;
  const int wg = blockIdx.x * 4 + (tid_ >> 6), nw = gridDim.x * 4;
  const int* IDX = (const int*)(p.ws + OFF_IDX); const float* GP = (const float*)(p.ws + OFF_GP);
  const unsigned char* U8 = p.ws + OFF_U8; const unsigned char* V8 = p.ws + OFF_V8;
  const float* SCU = (const float*)(p.ws + OFF_SC8); const float* SCV = SCU + 16384;
  float* HW = (float*)(p.ws + OFF_HW);
  for (int t = wg; t < T_; t += nw) {
    const float* irow = p.out + (size_t)t * D_ + lane * 16;
    float x[16];
#pragma unroll
    for (int i = 0; i < 4; ++i) { const float4 v = ((const float4*)irow)[i]; x[4 * i] = v.x; x[4 * i + 1] = v.y; x[4 * i + 2] = v.z; x[4 * i + 3] = v.w; }
    const int id0 = IDX[(size_t)t * 128 + lane], id1 = IDX[(size_t)t * 128 + 64 + lane];
    const float gu0 = GP[(size_t)t * 128 + lane], gu1 = GP[(size_t)t * 128 + 64 + lane];
    const float su0 = SCU[id0], su1 = SCU[id1], sv0 = SCV[id0], sv1 = SCV[id1];
    float hw0 = 0.f, hw1 = 0.f;
    uint4 ca[8];
#pragma unroll
    for (int k = 0; k < 8; ++k) { const int id = __builtin_amdgcn_readlane(id0, k); ca[k] = *(const uint4*)(U8 + (size_t)id * 1024 + lane * 16); }
    for (int gi = 0; gi < 16; ++gi) {
      uint4 na[8];
      if (gi < 15) {
        const int idh = (gi + 1 < 8) ? id0 : id1;
#pragma unroll
        for (int k = 0; k < 8; ++k) { const int id = __builtin_amdgcn_readlane(idh, ((gi + 1) & 7) * 8 + k); na[k] = *(const uint4*)(U8 + (size_t)id * 1024 + lane * 16); }
      }
      float pt[8];
#pragma unroll
      for (int k = 0; k < 8; ++k) pt[k] = dot16f8(ca[k], x);
#pragma unroll
      for (int i = 0; i < 4; ++i) { const bool up = lane & 4; const float keep = up ? pt[i + 4] : pt[i]; const float send = up ? pt[i] : pt[i + 4]; pt[i] = keep + SWZ_XOR(send, 4); }
#pragma unroll
      for (int i = 0; i < 2; ++i) { const bool up = lane & 2; const float keep = up ? pt[i + 2] : pt[i]; const float send = up ? pt[i] : pt[i + 2]; pt[i] = keep + SWZ_XOR(send, 2); }
      { const bool up = lane & 1; const float keep = up ? pt[1] : pt[0]; const float send = up ? pt[0] : pt[1]; pt[0] = keep + SWZ_XOR(send, 1); }
      float tot = pt[0];
      tot += SWZ_XOR(tot, 8); tot += SWZ_XOR(tot, 16); tot = xor32_sum(tot);
      if ((lane >> 3) == (gi & 7)) { if (gi < 8) hw0 = gu0 * gelu_tanh(tot * su0) * sv0; else hw1 = gu1 * gelu_tanh(tot * su1) * sv1; }
      if (gi < 15) {
#pragma unroll
        for (int k = 0; k < 8; ++k) ca[k] = na[k];
      }
    }
    HW[(size_t)t * 128 + lane] = gu0 * gelu_tanh(hw0 * su0) * sv0; HW[(size_t)t * 128 + 64 + lane] = gu1 * gelu_tanh(hw1 * su1) * sv1;
  }
  for (int t = wg; t < T_; t += nw) {
    const int id0 = IDX[(size_t)t * 128 + lane], id1 = IDX[(size_t)t * 128 + 64 + lane];
    const float hw0 = HW[(size_t)t * 128 + lane], hw1 = HW[(size_t)t * 128 + 64 + lane];
    float acc[16];
#pragma unroll
    for (int i = 0; i < 16; ++i) acc[i] = 0.f;
    {
      uint4 ca[8];
#pragma unroll
      for (int k = 0; k < 8; ++k) { const int id = __builtin_amdgcn_readlane(id0, k); ca[k] = *(const uint4*)(V8 + (size_t)id * 1024 + lane * 16); }
      for (int gi = 0; gi < 16; ++gi) {
        uint4 na[8];
        if (gi < 15) {
          const int idh = (gi + 1 < 8) ? id0 : id1;
#pragma unroll
          for (int k = 0; k < 8; ++k) { const int id = __builtin_amdgcn_readlane(idh, ((gi + 1) & 7) * 8 + k); na[k] = *(const uint4*)(V8 + (size_t)id * 1024 + lane * 16); }
        }
        const float hwh = (gi < 8) ? hw0 : hw1;
#pragma unroll
        for (int k = 0; k < 8; ++k) {
          const float w = __int_as_float(__builtin_amdgcn_readlane(__float_as_int(hwh), (gi & 7) * 8 + k));
          axpy16f8(ca[k], w, acc);
        }
        if (gi < 15) {
#pragma unroll
          for (int k = 0; k < 8; ++k) ca[k] = na[k];
        }
      }
    }
    const float* irow = p.out + (size_t)t * D_ + lane * 16;
    float x[16];
#pragma unroll
    for (int i = 0; i < 4; ++i) { const float4 v = ((const float4*)irow)[i]; x[4 * i] = v.x; x[4 * i + 1] = v.y; x[4 * i + 2] = v.z; x[4 * i + 3] = v.w; }
    float* orow = dummy ? (float*)(p.ws + OFF_KVC) + (size_t)(t & 8191) * D_ + lane * 16 : p.out + (size_t)t * D_ + lane * 16;
    float sum = 0.f;
#pragma unroll
    for (int i = 0; i < 16; ++i) { x[i] = ALPHA * x[i] + acc[i]; sum += x[i]; }
    const float mu = wave_sum(sum) * (1.f / D_);
    float vs = 0.f;
#pragma unroll
    for (int i = 0; i < 16; ++i) { x[i] -= mu; vs += x[i] * x[i]; }
    const float rs = rsqrtf(wave_sum(vs) * (1.f / D_) + 1e-5f);
    const float4* gg = (const float4*)(p.in[I_LNFG] + lane * 16); const float4* bb = (const float4*)(p.in[I_LNFB] + lane * 16);
#pragma unroll
    for (int i = 0; i < 4; ++i) {
      float4 g4 = gg[i], b4 = bb[i];
      ((float4*)orow)[i] = make_float4(x[4 * i] * rs * g4.x + b4.x, x[4 * i + 1] * rs * g4.y + b4.y, x[4 * i + 2] * rs * g4.z + b4.z, x[4 * i + 3] * rs * g4.w + b4.w);
    }
  }
}

typedef __attribute__((ext_vector_type(16))) float f32x16v;
typedef __attribute__((ext_vector_type(32))) float f32x32v;
typedef __attribute__((ext_vector_type(6))) unsigned u32x6v;
DEV float half_max(float v) { v = fmaxf(v, SWZ_XOR(v, 1)); v = fmaxf(v, SWZ_XOR(v, 2)); v = fmaxf(v, SWZ_XOR(v, 4)); v = fmaxf(v, SWZ_XOR(v, 8)); v = fmaxf(v, SWZ_XOR(v, 16)); return v; }
DEV float half_sum(float v) { v += SWZ_XOR(v, 1); v += SWZ_XOR(v, 2); v += SWZ_XOR(v, 4); v += SWZ_XOR(v, 8); v += SWZ_XOR(v, 16); return v; }
DEV void ph_conv_tables6(const Params& p, int wv) {
  const int tid_ = opaque_tid(wv);
  const int lane = tid_ & 63, l31 = lane & 31, lh = lane >> 5;
  const int wg = blockIdx.x * 4 + (tid_ >> 6), nw = gridDim.x * 4;
  for (int rp = wg; rp < 16384; rp += nw) {
    const int rr = 2 * rp + lh, tb = rr >> 14, row = rr & 16383;
    const float* src = (tb ? p.in[I_PV] : p.in[I_PU]) + (size_t)row * 1024 + l31 * 32;
    f32x16v a, b;
    float mx = 0.f;
#pragma unroll
    for (int i = 0; i < 8; ++i) { const float4 v = ((const float4*)src)[i]; a[2 * i] = v.x; b[2 * i] = v.y; a[2 * i + 1] = v.z; b[2 * i + 1] = v.w; }
#pragma unroll
    for (int i = 0; i < 16; ++i) mx = fmaxf(mx, fmaxf(fabsf(a[i]), fabsf(b[i])));
    mx = half_max(mx);
    const float sc = mx > 0.f ? 7.5f / mx : 0.f;
#pragma unroll
    for (int i = 0; i < 16; ++i) { a[i] *= sc; b[i] *= sc; }
    const u32x6v w = __builtin_amdgcn_cvt_scalef32_2xpk16_fp6_f32(a, b, 1.0f);
    unsigned char* dst = p.ws + (tb ? OFF_V6 : OFF_U6) + (size_t)row * 768 + l31 * 8;
    *(uint2*)dst = make_uint2(w[0], w[1]); *(uint2*)(dst + 256) = make_uint2(w[2], w[3]); *(uint2*)(dst + 512) = make_uint2(w[4], w[5]);
    if (l31 == 0) ((float*)(p.ws + OFF_SC8))[rr] = mx * (1.f / 7.5f);
  }
}

DEV u32x6v ld24(const unsigned char* ptr) {
  const uint2 a = *(const uint2*)ptr, b = *(const uint2*)(ptr + 256), c = *(const uint2*)(ptr + 512);
  u32x6v w; w[0] = a.x; w[1] = a.y; w[2] = b.x; w[3] = b.y; w[4] = c.x; w[5] = c.y; return w;
}
DEV void ph_peer_gather6(const Params& p, int dummy, int wv) {
  const int tid_ = opaque_tid(wv);
  const int lane = tid_ & 63, l31 = lane & 31, lh = lane >> 5;
  const int wg = blockIdx.x * 4 + wv, nw = gridDim.x * 4;
  const int* IDX = (const int*)(p.ws + OFF_IDX); const float* GP = (const float*)(p.ws + OFF_GP);
  const unsigned char* U6 = p.ws + OFF_U6; const unsigned char* V6 = p.ws + OFF_V6;
  const float* SCU = (const float*)(p.ws + OFF_SC8); const float* SCV = SCU + 16384;
  float* HW = (float*)(p.ws + OFF_HW);
  for (int t = wg; t < T_; t += nw) {
    float x[32];
    {
      const float4* irow = (const float4*)(p.out + (size_t)t * D_ + l31 * 32);
#pragma unroll
      for (int i = 0; i < 8; ++i) { const float4 v = irow[i]; x[4 * i] = v.x; x[4 * i + 1] = v.y; x[4 * i + 2] = v.z; x[4 * i + 3] = v.w; }
    }
    const int id0 = IDX[(size_t)t * 128 + lane], id1 = IDX[(size_t)t * 128 + 64 + lane];
    const float gu0 = GP[(size_t)t * 128 + lane], gu1 = GP[(size_t)t * 128 + 64 + lane];
    const float su0 = SCU[id0], su1 = SCU[id1], sv0 = SCV[id0], sv1 = SCV[id1];
    float hw0 = 0.f, hw1 = 0.f;
    u32x6v ca[4];
#pragma unroll
    for (int q = 0; q < 4; ++q) { const int ida = __builtin_amdgcn_readlane(id0, 2 * q), idb = __builtin_amdgcn_readlane(id0, 2 * q + 1); ca[q] = ld24(U6 + (size_t)(lh ? idb : ida) * 768 + l31 * 8); }
    for (int gi = 0; gi < 16; ++gi) {
      u32x6v na[4];
      if (gi < 15) {
        const int idh = (gi + 1 < 8) ? id0 : id1;
#pragma unroll
        for (int q = 0; q < 4; ++q) {
          const int ida = __builtin_amdgcn_readlane(idh, ((gi + 1) & 7) * 8 + 2 * q), idb = __builtin_amdgcn_readlane(idh, ((gi + 1) & 7) * 8 + 2 * q + 1);
          na[q] = ld24(U6 + (size_t)(lh ? idb : ida) * 768 + l31 * 8);
        }
      }
      float pt[4];
#pragma unroll
      for (int q = 0; q < 4; ++q) {
        const f32x32v r = __builtin_amdgcn_cvt_scalef32_pk32_f32_fp6(ca[q], 1.0f);
        float s0 = 0.f, s1 = 0.f, s2 = 0.f, s3 = 0.f;
#pragma unroll
        for (int j = 0; j < 32; j += 4) { s0 += r[j] * x[j]; s1 += r[j + 1] * x[j + 1]; s2 += r[j + 2] * x[j + 2]; s3 += r[j + 3] * x[j + 3]; }
        pt[q] = (s0 + s1) + (s2 + s3);
      }
#pragma unroll
      for (int i = 0; i < 2; ++i) { const bool up = lane & 2; const float keep = up ? pt[i + 2] : pt[i]; const float send = up ? pt[i] : pt[i + 2]; pt[i] = keep + SWZ_XOR(send, 2); }
      { const bool up = lane & 1; const float keep = up ? pt[1] : pt[0]; const float send = up ? pt[0] : pt[1]; pt[0] = keep + SWZ_XOR(send, 1); }
      float tot = pt[0];
      tot += SWZ_XOR(tot, 4); tot += SWZ_XOR(tot, 8); tot += SWZ_XOR(tot, 16);
      const int srcl = ((lane & 1) << 5) | ((lane & 7) >> 1);
      const float mine = __int_as_float(__builtin_amdgcn_ds_bpermute(srcl << 2, __float_as_int(tot)));
      if ((lane >> 3) == (gi & 7)) { if (gi < 8) hw0 = mine; else hw1 = mine; }
      if (gi < 15) {
#pragma unroll
        for (int q = 0; q < 4; ++q) ca[q] = na[q];
      }
    }
    HW[(size_t)t * 128 + lane] = gu0 * gelu_tanh(hw0 * su0) * sv0; HW[(size_t)t * 128 + 64 + lane] = gu1 * gelu_tanh(hw1 * su1) * sv1;
  }
  for (int t = wg; t < T_; t += nw) {
    const int id0 = IDX[(size_t)t * 128 + lane], id1 = IDX[(size_t)t * 128 + 64 + lane];
    const float hw0 = HW[(size_t)t * 128 + lane], hw1 = HW[(size_t)t * 128 + 64 + lane];
    float acc[32];
#pragma unroll
    for (int j = 0; j < 32; ++j) acc[j] = 0.f;
    {
      u32x6v ca[4];
#pragma unroll
      for (int q = 0; q < 4; ++q) { const int ida = __builtin_amdgcn_readlane(id0, 2 * q), idb = __builtin_amdgcn_readlane(id0, 2 * q + 1); ca[q] = ld24(V6 + (size_t)(lh ? idb : ida) * 768 + l31 * 8); }
      for (int gi = 0; gi < 16; ++gi) {
        u32x6v na[4];
        if (gi < 15) {
          const int idh = (gi + 1 < 8) ? id0 : id1;
#pragma unroll
          for (int q = 0; q < 4; ++q) {
            const int ida = __builtin_amdgcn_readlane(idh, ((gi + 1) & 7) * 8 + 2 * q), idb = __builtin_amdgcn_readlane(idh, ((gi + 1) & 7) * 8 + 2 * q + 1);
            na[q] = ld24(V6 + (size_t)(lh ? idb : ida) * 768 + l31 * 8);
          }
        }
        const float hwh = (gi < 8) ? hw0 : hw1;
#pragma unroll
        for (int q = 0; q < 4; ++q) {
          const float wa = __int_as_float(__builtin_amdgcn_readlane(__float_as_int(hwh), (gi & 7) * 8 + 2 * q));
          const float wb = __int_as_float(__builtin_amdgcn_readlane(__float_as_int(hwh), (gi & 7) * 8 + 2 * q + 1));
          const float w = lh ? wb : wa;
          const f32x32v r = __builtin_amdgcn_cvt_scalef32_pk32_f32_fp6(ca[q], 1.0f);
#pragma unroll
          for (int j = 0; j < 32; ++j) acc[j] += w * r[j];
        }
        if (gi < 15) {
#pragma unroll
          for (int q = 0; q < 4; ++q) ca[q] = na[q];
        }
      }
    }
    const float4* irow = (const float4*)(p.out + (size_t)t * D_ + l31 * 32);
    float y[32]; float sum = 0.f;
#pragma unroll
    for (int i = 0; i < 8; ++i) {
      const float4 v = irow[i];
      y[4 * i] = ALPHA * v.x + xor32_sum(acc[4 * i]); y[4 * i + 1] = ALPHA * v.y + xor32_sum(acc[4 * i + 1]);
      y[4 * i + 2] = ALPHA * v.z + xor32_sum(acc[4 * i + 2]); y[4 * i + 3] = ALPHA * v.w + xor32_sum(acc[4 * i + 3]);
      sum += y[4 * i] + y[4 * i + 1] + y[4 * i + 2] + y[4 * i + 3];
    }
    const float mu = half_sum(sum) * (1.f / D_);
    float vs = 0.f;
#pragma unroll
    for (int j = 0; j < 32; ++j) { y[j] -= mu; vs += y[j] * y[j]; }
    const float rs = rsqrtf(half_sum(vs) * (1.f / D_) + 1e-5f);
    float* orow = (dummy ? (float*)(p.ws + OFF_KVC) + (size_t)(t & 8191) * D_ : p.out + (size_t)t * D_) + l31 * 32;
    const float4* gg = (const float4*)(p.in[I_LNFG] + l31 * 32); const float4* bb = (const float4*)(p.in[I_LNFB] + l31 * 32);
#pragma unroll
    for (int i = 0; i < 8; ++i) {
      if ((i >> 2) == lh) {
        const float4 g4 = gg[i], b4 = bb[i];
        ((float4*)orow)[i] = make_float4(y[4 * i] * rs * g4.x + b4.x, y[4 * i + 1] * rs * g4.y + b4.y, y[4 * i + 2] * rs * g4.z + b4.z, y[4 * i + 3] * rs * g4.w + b4.w);
      }
    }
  }
}

DEV unsigned f2key(float f) { unsigned u = __float_as_uint(f); return u ^ ((unsigned)((int)u >> 31) | 0x80000000u); }
DEV float key2f(unsigned k) { return __uint_as_float((k & 0x80000000u) ? (k ^ 0x80000000u) : ~k); }
DEV void sort16_desc(unsigned (&v)[16]) {
#pragma unroll
  for (int k = 2; k <= 16; k <<= 1) {
#pragma unroll
    for (int j = k >> 1; j > 0; j >>= 1) {
#pragma unroll
      for (int i = 0; i < 16; ++i) {
        const int l = i ^ j;
        if (l > i) {
          const bool desc = ((i & k) == 0);
          const unsigned a = v[i], b = v[l];
          const unsigned hi = a > b ? a : b, lo = a > b ? b : a;
          v[i] = desc ? hi : lo; v[l] = desc ? lo : hi;
        }
      }
    }
  }
}
DEV void merge16_desc(unsigned (&a)[16], const unsigned (&b)[16]) {
#pragma unroll
  for (int i = 0; i < 16; ++i) { const unsigned x = a[i], y = b[15 - i]; a[i] = x > y ? x : y; }
#pragma unroll
  for (int j = 8; j > 0; j >>= 1) {
#pragma unroll
    for (int i = 0; i < 16; ++i) {
      const int l = i ^ j;
      if (l > i) { const unsigned x = a[i], y = a[l]; a[i] = x > y ? x : y; a[l] = x > y ? y : x; }
    }
  }
}


template <int pp>
DEV void qtopk_half(const unsigned char* lds, const bf16_t* SK, int h, int trow, int l31, int lh, unsigned* lists) {
  bf16x8 qf[4];
#pragma unroll
  for (int s = 0; s < 4; ++s) qf[s] = *(const bf16x8*)(lds + trow * 256 + (((pp * 8 + 2 * s + lh) ^ (trow & 15)) << 4));
  unsigned best[16];
#pragma unroll
  for (int i = 0; i < 16; ++i) best[i] = 0u;
#pragma unroll 1
  for (int nb = 0; nb < 4; ++nb) {
    f32x16 S;
#pragma unroll
    for (int r = 0; r < 16; ++r) S[r] = 0.f;
#pragma unroll
    for (int s = 0; s < 4; ++s) {
      const bf16x8 kf = *(const bf16x8*)(SK + ((size_t)((h * 2 + pp) * 128 + 32 * nb + l31)) * 64 + 16 * s + 8 * lh);
      S = __builtin_amdgcn_mfma_f32_32x32x16_bf16(kf, qf[s], S, 0, 0, 0);
    }
    unsigned blk[16];
#pragma unroll
    for (int r = 0; r < 16; ++r) {
      const unsigned n = 32 * nb + (r & 3) + 8 * (r >> 2) + 4 * lh;
      blk[r] = (f2key(S[r]) & ~127u) | n;
    }
    sort16_desc(blk);
    merge16_desc(best, blk);
  }
  unsigned other[16];
#pragma unroll
  for (int i = 0; i < 16; ++i) other[i] = xor32_get(best[i], lh);
  merge16_desc(best, other);
  if (lh == pp) {
#pragma unroll
    for (int i = 0; i < 16; ++i) lists[trow * 32 + pp * 16 + i] = best[i];
  }
}

DEV void ph_peer_qtopk(const Params& p, unsigned char* lds, int wv) {
  const int tid = opaque_tid(wv), lane = tid & 63, w = tid >> 6, wm = w >> 1, wn = w & 1, l31 = lane & 31, lh = lane >> 5;
  const bf16_t* XB = (const bf16_t*)(p.ws + OFF_HB);
  const bf16_t* WQ = (const bf16_t*)(p.ws + W_Q);
  const bf16_t* SK = (const bf16_t*)(p.ws + W_SK);
  int* IDX = (int*)(p.ws + OFF_IDX); float* GP = (float*)(p.ws + OFF_GP);
  unsigned* lists = (unsigned*)(lds + 32768);
  const int nitems = (T_ / 128) * 8;
  for (int item = blockIdx.x; item < nitems; item += gridDim.x) {
    const int m0 = (item >> 3) * 128, h = item & 7;
    f32x16 acc[2][2];
    mfma_gemm_mainloop(XB, 1024, WQ, 1024, 1024, m0, h * 128, lds, acc, wv);
#pragma unroll
    for (int i = 0; i < 2; ++i)
#pragma unroll
      for (int j = 0; j < 2; ++j)
#pragma unroll
        for (int r = 0; r < 16; ++r) {
          const int row = wm * 64 + i * 32 + (r & 3) + 8 * (r >> 2) + 4 * lh, col = wn * 64 + j * 32 + l31;
          *(bf16_t*)(lds + row * 256 + ((((col >> 3) ^ (row & 15))) << 4) + (col & 7) * 2) = f2bf(acc[i][j][r]);
        }
    __syncthreads();
    const int trow = 32 * w + l31;
    qtopk_half<0>(lds, SK, h, trow, l31, lh, lists);
    qtopk_half<1>(lds, SK, h, trow, l31, lh, lists);
    float f1[16], f2v[16];
#pragma unroll
    for (int i = 0; i < 16; ++i) { f1[i] = key2f(lists[trow * 32 + i] & ~127u); f2v[i] = key2f(lists[trow * 32 + 16 + i] & ~127u); }
    unsigned cd[4][16];
    cd[0][0] = (f2key(f1[0] + f2v[0]) & ~255u) | 0u;
    cd[0][1] = (f2key(f1[0] + f2v[1]) & ~255u) | 1u;
    cd[0][2] = (f2key(f1[0] + f2v[2]) & ~255u) | 2u;
    cd[0][3] = (f2key(f1[0] + f2v[3]) & ~255u) | 3u;
    cd[0][4] = (f2key(f1[0] + f2v[4]) & ~255u) | 4u;
    cd[0][5] = (f2key(f1[0] + f2v[5]) & ~255u) | 5u;
    cd[0][6] = (f2key(f1[0] + f2v[6]) & ~255u) | 6u;
    cd[0][7] = (f2key(f1[0] + f2v[7]) & ~255u) | 7u;
    cd[0][8] = (f2key(f1[0] + f2v[8]) & ~255u) | 8u;
    cd[0][9] = (f2key(f1[0] + f2v[9]) & ~255u) | 9u;
    cd[0][10] = (f2key(f1[0] + f2v[10]) & ~255u) | 10u;
    cd[0][11] = (f2key(f1[0] + f2v[11]) & ~255u) | 11u;
    cd[0][12] = (f2key(f1[0] + f2v[12]) & ~255u) | 12u;
    cd[0][13] = (f2key(f1[0] + f2v[13]) & ~255u) | 13u;
    cd[0][14] = (f2key(f1[0] + f2v[14]) & ~255u) | 14u;
    cd[0][15] = (f2key(f1[0] + f2v[15]) & ~255u) | 15u;
    cd[1][0] = (f2key(f1[1] + f2v[0]) & ~255u) | 16u;
    cd[1][1] = (f2key(f1[1] + f2v[1]) & ~255u) | 17u;
    cd[1][2] = (f2key(f1[1] + f2v[2]) & ~255u) | 18u;
    cd[1][3] = (f2key(f1[1] + f2v[3]) & ~255u) | 19u;
    cd[1][4] = (f2key(f1[1] + f2v[4]) & ~255u) | 20u;
    cd[1][5] = (f2key(f1[1] + f2v[5]) & ~255u) | 21u;
    cd[1][6] = (f2key(f1[1] + f2v[6]) & ~255u) | 22u;
    cd[1][7] = (f2key(f1[1] + f2v[7]) & ~255u) | 23u;
    cd[1][8] = (f2key(f1[2] + f2v[0]) & ~255u) | 32u;
    cd[1][9] = (f2key(f1[2] + f2v[1]) & ~255u) | 33u;
    cd[1][10] = (f2key(f1[2] + f2v[2]) & ~255u) | 34u;
    cd[1][11] = (f2key(f1[2] + f2v[3]) & ~255u) | 35u;
    cd[1][12] = (f2key(f1[2] + f2v[4]) & ~255u) | 36u;
    cd[1][13] = (f2key(f1[3] + f2v[0]) & ~255u) | 48u;
    cd[1][14] = (f2key(f1[3] + f2v[1]) & ~255u) | 49u;
    cd[1][15] = (f2key(f1[3] + f2v[2]) & ~255u) | 50u;
    cd[2][0] = (f2key(f1[3] + f2v[3]) & ~255u) | 51u;
    cd[2][1] = (f2key(f1[4] + f2v[0]) & ~255u) | 64u;
    cd[2][2] = (f2key(f1[4] + f2v[1]) & ~255u) | 65u;
    cd[2][3] = (f2key(f1[4] + f2v[2]) & ~255u) | 66u;
    cd[2][4] = (f2key(f1[5] + f2v[0]) & ~255u) | 80u;
    cd[2][5] = (f2key(f1[5] + f2v[1]) & ~255u) | 81u;
    cd[2][6] = (f2key(f1[6] + f2v[0]) & ~255u) | 96u;
    cd[2][7] = (f2key(f1[6] + f2v[1]) & ~255u) | 97u;
    cd[2][8] = (f2key(f1[7] + f2v[0]) & ~255u) | 112u;
    cd[2][9] = (f2key(f1[7] + f2v[1]) & ~255u) | 113u;
    cd[2][10] = (f2key(f1[8] + f2v[0]) & ~255u) | 128u;
    cd[2][11] = (f2key(f1[9] + f2v[0]) & ~255u) | 144u;
    cd[2][12] = (f2key(f1[10] + f2v[0]) & ~255u) | 160u;
    cd[2][13] = (f2key(f1[11] + f2v[0]) & ~255u) | 176u;
    cd[2][14] = (f2key(f1[12] + f2v[0]) & ~255u) | 192u;
    cd[2][15] = (f2key(f1[13] + f2v[0]) & ~255u) | 208u;
    cd[3][0] = (f2key(f1[14] + f2v[0]) & ~255u) | 224u;
    cd[3][1] = (f2key(f1[15] + f2v[0]) & ~255u) | 240u;
    cd[3][2] = 0u;
    cd[3][3] = 0u;
    cd[3][4] = 0u;
    cd[3][5] = 0u;
    cd[3][6] = 0u;
    cd[3][7] = 0u;
    cd[3][8] = 0u;
    cd[3][9] = 0u;
    cd[3][10] = 0u;
    cd[3][11] = 0u;
    cd[3][12] = 0u;
    cd[3][13] = 0u;
    cd[3][14] = 0u;
    cd[3][15] = 0u;
#pragma unroll
    for (int q = 0; q < 4; ++q) sort16_desc(cd[q]);
    merge16_desc(cd[0], cd[1]); merge16_desc(cd[2], cd[3]); merge16_desc(cd[0], cd[2]);
    float ev[16]; float sm = 0.f;
    const float mx = key2f(cd[0][0] & ~255u);
#pragma unroll
    for (int i = 0; i < 16; ++i) { ev[i] = __expf(key2f(cd[0][i] & ~255u) - mx); sm += ev[i]; }
    const float inv = 1.f / sm;
    const size_t ob = (size_t)(m0 + trow) * 128 + h * 16;
#pragma unroll
    for (int i = 0; i < 16; ++i) {
      if ((i >> 3) == lh) {
        const unsigned code = cd[0][i] & 255u;
        const unsigned i1 = lists[trow * 32 + (code >> 4)] & 127u, i2 = lists[trow * 32 + 16 + (code & 15u)] & 127u;
        IDX[ob + i] = (int)(i1 * 128u + i2);
        GP[ob + i] = ev[i] * inv;
      }
    }
    __syncthreads();
  }
}

DEV void ph_merge2(const Params& p, unsigned char* lds, int wv) {
  const bf16_t* GS = (const bf16_t*)p.out; bf16_t* M = (bf16_t*)(p.ws + OFF_M);
  const bf16_t* YN = (const bf16_t*)(p.ws + OFF_YNSA); const bf16_t* YR = (const bf16_t*)(p.ws + OFF_YRWKV);
  const bf16_t* WN = (const bf16_t*)(p.ws + W_N); const bf16_t* WR = (const bf16_t*)(p.ws + W_R);
  for (int item = blockIdx.x; item < (T_ / 128) * 8; item += gridDim.x) {
    const int m0 = (item >> 3) * 128, n0 = (item & 7) * 128;
    f32x16 acc[2][2];
    mfma_gemm_mainloop<true>(YN, 512, WN, 512, 512, m0, n0, lds, acc, wv);
    const int tid = opaque_tid(wv), lane = tid & 63, w = tid >> 6, wm = w >> 1, wn = w & 1, l31 = lane & 31, lh = lane >> 5;
#pragma unroll
    for (int i = 0; i < 2; ++i)
#pragma unroll
      for (int j = 0; j < 2; ++j)
#pragma unroll
        for (int r = 0; r < 16; ++r) {
          const unsigned t = m0 + wm * 64 + i * 32 + (r & 3) + 8 * (r >> 2) + 4 * lh, n = n0 + wn * 64 + j * 32 + l31;
          const float g1 = bf2f(GS[t * 2048 + n]), g2 = bf2f(GS[t * 2048 + 1024 + n]);
          acc[i][j][r] *= g1 / fmaxf(g2, 1e-30f);
        }
    mfma_gemm_mainloop<false>(YR, 512, WR, 512, 512, m0, n0, lds, acc, wv);
#pragma unroll
    for (int i = 0; i < 2; ++i)
#pragma unroll
      for (int j = 0; j < 2; ++j)
#pragma unroll
        for (int r = 0; r < 16; ++r) {
          const unsigned t = m0 + wm * 64 + i * 32 + (r & 3) + 8 * (r >> 2) + 4 * lh, n = n0 + wn * 64 + j * 32 + l31;
          M[t * 1024 + n] = f2bf(fmaxf(bf2f(GS[t * 2048 + 1024 + n]), 1e-30f) * acc[i][j][r]);
        }
  }
}

#define XB_TMO      128
#define XB_XCNT(j)  (256  + 64 * (j))
#define XB_XSUB(j)  (1280 + 64 * (j))
#define XB_XGEN(j)  (2304 + 64 * (j))
#define XB_TOP      3328
#define XB_TOPGEN   3392
#define XCD_BAR_WORDS 3456
#define XB_SPIN_CAP (1u << 22)
#define LAS __attribute__((address_space(3)))
DEV unsigned xb_ld(unsigned* p) { return __hip_atomic_load(p, __ATOMIC_RELAXED, __HIP_MEMORY_SCOPE_AGENT); }
DEV unsigned xb_add(unsigned* p, unsigned v) { return __hip_atomic_fetch_add(p, v, __ATOMIC_RELAXED, __HIP_MEMORY_SCOPE_AGENT); }
DEV unsigned xb_xcc_id() { return (unsigned)__builtin_amdgcn_s_getreg((3 << 11) | 20) & 0xFu; }
#define XB_SPIN(cond, bar) do { unsigned _sp = 0; while (cond) { __builtin_amdgcn_s_sleep(1); \
    if ((++_sp & 255u) == 0u) { if (xb_ld(&(bar)[XB_TMO])) break; if (_sp > XB_SPIN_CAP) { atomicAdd(&(bar)[XB_TMO], 1u); break; } } } } while (0)
struct XcdBarrier { unsigned* bar; unsigned x; volatile LAS unsigned* st; int wv; };
DEV XcdBarrier xcd_barrier_post(unsigned* bar, volatile LAS unsigned* st) {
  XcdBarrier b; b.bar = bar; b.x = xb_xcc_id(); b.st = st;
  if (threadIdx.x == 0) (void)xb_add(&bar[XB_XCNT(b.x)], 1u);
  return b;
}
DEV void xcd_barrier_complete(unsigned* bar, unsigned x, unsigned& nloc, unsigned& nx) {
  const unsigned G = gridDim.x * gridDim.y * gridDim.z;
  unsigned sum, cnt, mine, sp = 0u;
  for (;;) {
    sum = 0u; cnt = 0u; mine = 0u;
#pragma unroll
    for (unsigned j = 0; j < 16; ++j) { const unsigned c = xb_ld(&bar[XB_XCNT(j)]); sum += c; cnt += (c > 0u) ? 1u : 0u; mine = (j == x) ? c : mine; }
    if (sum == G) break;
    __builtin_amdgcn_s_sleep(1);
    if ((++sp & 255u) == 0u) { if (xb_ld(&bar[XB_TMO])) break; if (sp > XB_SPIN_CAP) { atomicAdd(&bar[XB_TMO], 1u); break; } }
  }
  nloc = mine > 0u ? mine : 1u; nx = cnt > 0u ? cnt : 1u;
}
DEV void xcd_barrier(const XcdBarrier& b) {
  asm volatile("s_waitcnt vmcnt(0)" ::: "memory");
  __syncthreads();
  if (opaque_tid(b.wv) == 0) {
    unsigned* bar = b.bar;
    __builtin_amdgcn_s_waitcnt(0);
    unsigned nloc = b.st[0], nx = b.st[1];
    if (nloc == 0u) { xcd_barrier_complete(bar, b.x, nloc, nx); b.st[0] = nloc; b.st[1] = nx; }
    const unsigned old = xb_add(&bar[XB_XSUB(b.x)], 1u);
    const unsigned gen = old / nloc;
    if (old + 1u == (gen + 1u) * nloc) {
      __builtin_amdgcn_fence(__ATOMIC_RELEASE, "agent");
      asm volatile("s_waitcnt vmcnt(0)" ::: "memory");
      const unsigned og = xb_add(&bar[XB_TOP], 1u);
      const unsigned tg = og / nx;
      if (og + 1u == (tg + 1u) * nx) xb_add(&bar[XB_TOPGEN], 1u);
      else XB_SPIN(xb_ld(&bar[XB_TOPGEN]) == tg, bar);
      __builtin_amdgcn_fence(__ATOMIC_ACQUIRE, "agent");
      xb_add(&bar[XB_XGEN(b.x)], 1u);
      asm volatile("s_waitcnt vmcnt(0)" ::: "memory");
    } else {
      XB_SPIN(xb_ld(&bar[XB_XGEN(b.x)]) == gen, bar);
      __builtin_amdgcn_fence(__ATOMIC_ACQUIRE, "agent");
      asm volatile("s_waitcnt vmcnt(0)" ::: "memory");
    }
  }
  __syncthreads();
}

#define REP_Z 1
#define REP_CMP 1
#define REP_PREP 1
#define REP_NSA 1
#define REP_SCAN 1
#define REP_POSTGS 1
#define REP_QTOPK 1
#define REP_GATHER 1
#define REP_P0 1
#define REP_BAR 0
#define REP_P7 1
#define REP_POST 1
#define REP_MERGE 1
#define REP_OUT 1
__global__ void __launch_bounds__(256, 2) mega(Params p) {
  cg::grid_group grid = cg::this_grid();
  const int wv = __builtin_amdgcn_readfirstlane((int)(threadIdx.x >> 6));
  __shared__ __attribute__((aligned(16))) float lds[16384 + 4];
  unsigned char* ldsb = (unsigned char*)lds;
  bf16_t* HB = (bf16_t*)(p.ws + OFF_HB);
  unsigned* ctl = (unsigned*)(p.ws + OFF_CTL);
  if (threadIdx.x < 4) lds[16384 + threadIdx.x] = 0.f;
  __syncthreads();
  XcdBarrier xb = xcd_barrier_post((unsigned*)(p.ws + OFF_BAR), (volatile LAS unsigned*)(lds + 16384)); xb.wv = wv;
  for (int rep = 0; rep < REP_P0; ++rep) {
  ph_ln_wave(p.in[I_X], p.in[I_LNIN_G], p.in[I_LNIN_B], nullptr, HB, wv);
  {
    int it0 = 0; const int gsz = gridDim.x;
    conv_wT(p.in[I_WIN], DIN, 0, 1024, NZ, 3200, (bf16_t*)(p.ws + W_IN), lds, it0, gsz, wv);
    conv_wT(p.in[I_WIN], DIN, C_MG, 1024, 2048, 2048, (bf16_t*)(p.ws + W_G), lds, it0, gsz, wv);
    conv_wT(p.in[I_WON], 1024, 0, 512, 1024, 1024, (bf16_t*)(p.ws + W_N), lds, it0, gsz, wv);
    conv_wT(p.in[I_WOR], 1024, 0, 512, 1024, 1024, (bf16_t*)(p.ws + W_R), lds, it0, gsz, wv);
    conv_wT(p.in[I_WOUT], 1024, 0, 1024, 1024, 1024, (bf16_t*)(p.ws + W_OUT), lds, it0, gsz, wv);
    conv_wT(p.in[I_PWQ], 1024, 0, 1024, 1024, 1024, (bf16_t*)(p.ws + W_Q), lds, it0, gsz, wv);
    conv_wT(p.in[I_W2], 512, 0, 64, 512, 512, (bf16_t*)(p.ws + W_LW), lds, it0, gsz, wv);
    conv_wT(p.in[I_A2], 512, 0, 64, 512, 512, (bf16_t*)(p.ws + W_LA), lds, it0, gsz, wv);
    conv_wT(p.in[I_G2], 512, 0, 128, 512, 512, (bf16_t*)(p.ws + W_LG), lds, it0, gsz, wv);
    {
      bf16_t* W1C = (bf16_t*)(p.ws + W_C1T);
      for (int i = blockIdx.x * 256 + opaque_tid(wv); i < 2 * 256 * 256; i += gsz * 256) {
        const int n = i & 255, kc = (i >> 8) & 255, kv = i >> 16;
        const float* src = p.in[I_CW1] + ((size_t)kv * 2048 + kc * 8) * 256 + n;
        float f[8];
#pragma unroll
        for (int j = 0; j < 8; ++j) f[j] = src[j * 256];
        *(uint4*)(W1C + (size_t)i * 8) = pack8f(f);
      }
    }
    conv_wT(p.in[I_CW2], 64, 0, 256, 64, 64, (bf16_t*)(p.ws + W_C2T), lds, it0, gsz, wv);
    conv_wT(p.in[I_CW2] + 256 * 64, 64, 0, 256, 64, 64, (bf16_t*)(p.ws + W_C2T) + 64 * 256, lds, it0, gsz, wv);
    {
      float* C1 = (float*)(p.ws + W_C1);
      const int ln = opaque_tid(wv) & 63;
      for (int o = blockIdx.x * 4 + wv; o < 512; o += gsz * 4) {
        const int kv = o >> 8, n = o & 255;
        float a = 0.f;
#pragma unroll 16
        for (int e = ln; e < 2048; e += 64) a += p.in[I_CPOS][kv * 2048 + e] * p.in[I_CW1][((size_t)kv * 2048 + e) * 256 + n];
        a = wave_sum(a);
        if (ln == 0) C1[o] = a + p.in[I_CB1][o];
      }
    }
    { bf16_t* SK = (bf16_t*)(p.ws + W_SK); for (int i = blockIdx.x * 256 + opaque_tid(wv); i < 8 * 2 * 128 * 64; i += gsz * 256) SK[i] = f2bf(p.in[I_PSK][i]); }
  }
  }
  if (p.ws == nullptr) grid.sync();
  xcd_barrier(xb);
  {
    ZEpi e{(bf16_t*)(p.ws + OFF_Q), (bf16_t*)(p.ws + OFF_KVC), (bf16_t*)(p.ws + OFF_KSLC), (bf16_t*)(p.ws + OFF_KWIN),
           (bf16_t*)(p.ws + OFF_VSLCT), (bf16_t*)(p.ws + OFF_VWINT), (bf16_t*)p.out, (float*)(p.ws + OFF_GATE)};
    for (int rep = 0; rep < REP_Z; ++rep) { mfma_gemm(HB, 1024, (const bf16_t*)(p.ws + W_IN), 1024, 1024, T_, 3072, ldsb, e, wv); ph_ztail(p, e, wv); }
  }
  xcd_barrier(xb);
  for (int rep = 0; rep < REP_CMP; ++rep) ph_cmp2(p, ldsb, wv);
  for (int rep = 0; rep < REP_PREP; ++rep) ph_prep2(p, ldsb, wv);
  xcd_barrier(xb);
  for (int rep = 0; rep < REP_SCAN; ++rep) ph_scan2(p, lds, wv);
  for (int rep = 0; rep < REP_NSA; ++rep) ph_nsa_mfma(p, ldsb, ctl + rep, wv);
  xcd_barrier(xb);
  for (int rep = 0; rep < REP_POST; ++rep) ph_post_wave(p, wv);
  {
    bf16_t* GS = (bf16_t*)p.out;
    auto e = [=](int t, int n, float v) { GS[(unsigned)(t * 2048 + n)] = f2bf(sigm(v)); };
    for (int rep = 0; rep < REP_POSTGS; ++rep) mfma_gemm16(HB, 1024, (const bf16_t*)(p.ws + W_G), 1024, 1024, T_, 2048, ldsb, e, wv);
  }
  xcd_barrier(xb);
  for (int rep = 0; rep < REP_MERGE; ++rep) ph_merge2(p, ldsb, wv);
  xcd_barrier(xb);
  {
    float* Y1 = p.out;
    auto e = [=](int t, int n, float v) { Y1[(unsigned)(t * 1024 + n)] = ALPHA * bf2f(HB[(unsigned)(t * 1024 + n)]) + v; };
    for (int rep = 0; rep < REP_OUT; ++rep) mfma_gemm16((const bf16_t*)(p.ws + OFF_M), 1024, (const bf16_t*)(p.ws + W_OUT), 1024, 1024, T_, 1024, ldsb, e, wv);
  }
  xcd_barrier(xb);
  for (int rep = REP_P7 - 1; rep >= 0; --rep) {
    if (rep) ph_ln_wave(p.out, p.in[I_LNMG], p.in[I_LNMB], nullptr, (bf16_t*)(p.ws + OFF_KVC), wv);
    else ph_ln_wave(p.out, p.in[I_LNMG], p.in[I_LNMB], p.out, HB, wv);
    ph_conv_tables6(p, wv);
  }
  xcd_barrier(xb);
  for (int rep = 0; rep < REP_BAR; ++rep) xcd_barrier(xb);
  for (int rep = 0; rep < REP_QTOPK; ++rep) ph_peer_qtopk(p, ldsb, wv);
  xcd_barrier(xb);
  for (int rep = REP_GATHER - 1; rep >= 0; --rep) ph_peer_gather6(p, rep, wv);
}

extern "C" void kernel_launch(void* const* d_in, const int* in_sizes, int n_in, void* d_out, int out_size, void* d_ws, size_t ws_size, hipStream_t stream) {
  static int grid_blocks = 0;
  if (!grid_blocks) {
    int dev = 0, cus = 0, per_cu = 0;
    hipGetDevice(&dev);
    hipDeviceGetAttribute(&cus, hipDeviceAttributeMultiprocessorCount, dev);
    hipOccupancyMaxActiveBlocksPerMultiprocessor(&per_cu, mega, 256, 0);
    if (per_cu > 4) per_cu = 4;
    if (per_cu < 1) per_cu = 1;
    grid_blocks = cus * per_cu;
  }
  Params p{};
  for (int i = 0; i < 32; ++i) p.in[i] = (const float*)d_in[i];
  p.out = (float*)d_out;
  p.ws = (unsigned char*)d_ws;
  hipMemsetAsync((char*)d_ws + OFF_BAR, 0, 16384, stream);
  void* args[] = {&p};
  hipError_t e = hipLaunchCooperativeKernel((void*)mega, dim3(grid_blocks), dim3(256), args, 0, stream);
  if (e != hipSuccess) fprintf(stderr, "cooperative launch failed: %s (grid %d)\n", hipGetErrorString(e), grid_blocks);
}
```

```cpp
#include <hip/hip_runtime.h>
#include <hip/hip_cooperative_groups.h>
#include <cstdio>
namespace cg = cooperative_groups;

typedef unsigned short bf16_t;
#define DEV __device__ __forceinline__

constexpr int B_ = 8, S_ = 2048, T_ = B_ * S_, D_ = 1024;
constexpr int DIN = 5144;
constexpr int NZ = 3096;
constexpr int C_MG = 3096;
constexpr int RWC = 1792;
constexpr float ALPHA = 1.189207115002721f;
constexpr float NEGF = -1e30f;

enum { I_X = 0, I_LNIN_G, I_LNIN_B, I_RELB, I_WIN, I_MU, I_CPOS, I_CW1, I_CB1, I_CW2, I_CB2, I_W0, I_W2, I_A0, I_A2, I_G2,
       I_KK, I_KA, I_RK, I_LNXG, I_LNXB, I_WON, I_WOR, I_WOUT, I_LNMG, I_LNMB, I_PWQ, I_PSK, I_PU, I_PV, I_LNFG, I_LNFB };

constexpr size_t MiB = 1ull << 20;
constexpr size_t OFF_HB = 0;
constexpr size_t OFF_Q = OFF_HB + 32 * MiB;
constexpr size_t OFF_KVC = OFF_Q + 16 * MiB;
constexpr size_t OFF_KSLC = OFF_KVC + 8 * MiB;
constexpr size_t OFF_KWIN = OFF_KSLC + 4 * MiB;
constexpr size_t OFF_VSLCT = OFF_KWIN + 4 * MiB;
constexpr size_t OFF_VWINT = OFF_VSLCT + 4 * MiB;
constexpr size_t OFF_GATE = OFF_VWINT + 4 * MiB;
constexpr size_t OFF_KC = OFF_GATE + 1536 * 1024;
constexpr size_t OFF_VCT = OFF_KC + 256 * 1024;
constexpr size_t OFF_YNSA = OFF_VCT + 256 * 1024;
constexpr size_t OFF_YRWKV = OFF_YNSA + 16 * MiB;
constexpr size_t OFF_WTS = OFF_YRWKV + 16 * MiB;
constexpr size_t OFF_SCAN = OFF_WTS + 20 * MiB;
constexpr size_t OFF_R = OFF_SCAN;
constexpr size_t OFF_OMD = OFF_R + 16 * MiB;
constexpr size_t OFF_KP = OFF_OMD + 16 * MiB;
constexpr size_t OFF_V = OFF_KP + 16 * MiB;
constexpr size_t OFF_KB = OFF_V + 16 * MiB;
constexpr size_t OFF_G = OFF_KB + 32 * MiB;
constexpr size_t OFF_END = OFF_G + 16 * MiB;
constexpr size_t OFF_Y = OFF_END;
constexpr size_t W_IN = OFF_WTS;
constexpr size_t W_G = W_IN + 3200 * 1024 * 2;
constexpr size_t W_N = W_G + 2048 * 1024 * 2;
constexpr size_t W_R = W_N + 1024 * 512 * 2;
constexpr size_t W_OUT = W_R + 1024 * 512 * 2;
constexpr size_t W_Q = W_OUT + 1024 * 1024 * 2;
constexpr size_t W_SK = W_Q + 1024 * 1024 * 2;
constexpr size_t W_LW = W_SK + 8 * 2 * 128 * 64 * 2;
constexpr size_t W_LA = W_LW + 512 * 64 * 2;
constexpr size_t W_LG = W_LA + 512 * 64 * 2;
constexpr size_t W_C1T = W_LG + 512 * 128 * 2;
constexpr size_t W_C2T = W_C1T + 2 * 256 * 2048 * 2;
constexpr size_t W_C1 = W_C2T + 2 * 64 * 256 * 2;
constexpr size_t W_END = W_C1 + 2 * 256 * 4;
constexpr size_t OFF_BAR = OFF_WTS + 19 * MiB + 512 * 1024;
static_assert(W_END <= OFF_BAR, "weights region");
constexpr size_t OFF_CTL = OFF_BAR + 14336;
constexpr size_t OFF_MF = OFF_SCAN + 32 * MiB;
constexpr size_t OFF_M = OFF_SCAN;
constexpr size_t OFF_QP = OFF_SCAN;
constexpr size_t OFF_U16 = OFF_SCAN + 32 * MiB;
constexpr size_t OFF_V16 = OFF_SCAN + 64 * MiB;
constexpr size_t OFF_U8 = OFF_SCAN + 32 * MiB;
constexpr size_t OFF_V8 = OFF_SCAN + 48 * MiB;
constexpr size_t OFF_SC8 = OFF_SCAN + 64 * MiB;
constexpr size_t OFF_U6 = OFF_SCAN + 32 * MiB;
constexpr size_t OFF_V6 = OFF_SCAN + 48 * MiB;
constexpr size_t OFF_HW = OFF_SCAN + 72 * MiB;
constexpr size_t OFF_IDX = OFF_Q;
constexpr size_t OFF_GP = OFF_Q + 8 * MiB;

struct Params {
  const float* in[32];
  float* out;
  unsigned char* ws;
};

__device__ const unsigned char T5B[128] = {
  0, 1, 2, 3, 4, 5, 6, 7, 8, 9, 10, 11, 12, 13, 14, 15, 16, 16, 16, 17, 17, 18, 18, 18, 19, 19, 19, 20, 20, 20, 20, 21, 21, 21, 21,
  22, 22, 22, 22, 22, 23, 23, 23, 23, 23, 23, 24, 24, 24, 24, 24, 24, 25, 25, 25, 25, 25, 25, 25, 26, 26, 26, 26, 26, 26, 26, 26,
  27, 27, 27, 27, 27, 27, 27, 27, 27, 27, 28, 28, 28, 28, 28, 28, 28, 28, 28, 28, 29, 29, 29, 29, 29, 29, 29, 29, 29, 29, 29, 29,
  30, 30, 30, 30, 30, 30, 30, 30, 30, 30, 30, 30, 30, 30, 31, 31, 31, 31, 31, 31, 31, 31, 31, 31, 31, 31, 31, 31, 31};

DEV int opaque_tid(int wv) { int l; asm volatile("v_mbcnt_lo_u32_b32 %0, -1, 0\n\tv_mbcnt_hi_u32_b32 %0, -1, %0" : "=v"(l)); return wv * 64 + l; }
DEV float bf2f(bf16_t v) { return __uint_as_float(((unsigned)v) << 16); }
DEV bf16_t f2bf(float f) { unsigned u = __float_as_uint(f); u += 0x7fffu + ((u >> 16) & 1u); return (bf16_t)(u >> 16); }
DEV float sigm(float x) { return 1.f / (1.f + __expf(-x)); }
DEV float gelu_tanh(float x) { float u = 0.7978845608028654f * (x + 0.044715f * x * x * x); return 0.5f * x * (1.f + tanhf(u)); }
#define SWZ_XOR(v, K) __int_as_float(__builtin_amdgcn_ds_swizzle(__float_as_int(v), ((K) << 10) | 0x1F))
DEV float xor32_sum(float v) { auto r = __builtin_amdgcn_permlane32_swap(__float_as_uint(v), __float_as_uint(v), false, false); return __uint_as_float(r[0]) + __uint_as_float(r[1]); }
DEV float xor32_max(float v) { auto r = __builtin_amdgcn_permlane32_swap(__float_as_uint(v), __float_as_uint(v), false, false); return fmaxf(__uint_as_float(r[0]), __uint_as_float(r[1])); }
DEV unsigned xor32_get(unsigned v, int lh) { auto r = __builtin_amdgcn_permlane32_swap(v, v, false, false); return lh ? r[0] : r[1]; }
DEV float wave_sum(float v) { v += SWZ_XOR(v, 1); v += SWZ_XOR(v, 2); v += SWZ_XOR(v, 4); v += SWZ_XOR(v, 8); v += SWZ_XOR(v, 16); return xor32_sum(v); }
DEV float wave_max(float v) { v = fmaxf(v, SWZ_XOR(v, 1)); v = fmaxf(v, SWZ_XOR(v, 2)); v = fmaxf(v, SWZ_XOR(v, 4)); v = fmaxf(v, SWZ_XOR(v, 8)); v = fmaxf(v, SWZ_XOR(v, 16)); return xor32_max(v); }
DEV int t5bucket(int dist) { return T5B[dist > 127 ? 127 : dist]; }

DEV void ph_ln_wave(const float* in, const float* g, const float* b, float* of, bf16_t* ob, int wv) {
  const int tid_ = opaque_tid(wv);
  const int lane = tid_ & 63;
  const int wg = blockIdx.x * 4 + (tid_ >> 6), nw = gridDim.x * 4;
  float4 gg[4], bb[4];
#pragma unroll
  for (int i = 0; i < 4; ++i) { gg[i] = ((const float4*)g)[lane + 64 * i]; bb[i] = ((const float4*)b)[lane + 64 * i]; }
  for (int t = wg; t < T_; t += nw) {
    float4 v[4]; float s = 0.f;
#pragma unroll
    for (int i = 0; i < 4; ++i) { v[i] = ((const float4*)(in + (size_t)t * D_))[lane + 64 * i]; s += v[i].x + v[i].y + v[i].z + v[i].w; }
    const float mu = wave_sum(s) * (1.f / D_);
    float q = 0.f;
#pragma unroll
    for (int i = 0; i < 4; ++i) { v[i].x -= mu; v[i].y -= mu; v[i].z -= mu; v[i].w -= mu; q += v[i].x * v[i].x + v[i].y * v[i].y + v[i].z * v[i].z + v[i].w * v[i].w; }
    const float rs = rsqrtf(wave_sum(q) * (1.f / D_) + 1e-5f);
#pragma unroll
    for (int i = 0; i < 4; ++i) {
      float4 o = make_float4(v[i].x * rs * gg[i].x + bb[i].x, v[i].y * rs * gg[i].y + bb[i].y, v[i].z * rs * gg[i].z + bb[i].z, v[i].w * rs * gg[i].w + bb[i].w);
      if (of) ((float4*)(of + (size_t)t * D_))[lane + 64 * i] = o;
      if (ob) { ushort4 h; h.x = f2bf(o.x); h.y = f2bf(o.y); h.z = f2bf(o.z); h.w = f2bf(o.w); ((ushort4*)(ob + (size_t)t * D_))[lane + 64 * i] = h; }
    }
  }
}

DEV void unpack8(const uint4& u, float (&f)[8]) {
  f[0] = __uint_as_float(u.x << 16); f[1] = __uint_as_float(u.x & 0xffff0000u); f[2] = __uint_as_float(u.y << 16); f[3] = __uint_as_float(u.y & 0xffff0000u);
  f[4] = __uint_as_float(u.z << 16); f[5] = __uint_as_float(u.z & 0xffff0000u); f[6] = __uint_as_float(u.w << 16); f[7] = __uint_as_float(u.w & 0xffff0000u);
}
DEV float sum8lanes(float v) { v += SWZ_XOR(v, 1); v += SWZ_XOR(v, 2); v += SWZ_XOR(v, 4); return v; }
DEV void ph_post_wave(const Params& p, int wv) {
  const int tid_ = opaque_tid(wv);
  const int lane = tid_ & 63;
  const int wg = blockIdx.x * 4 + (tid_ >> 6), nw = gridDim.x * 4;
  const bf16_t* R = (const bf16_t*)(p.ws + OFF_R); const bf16_t* KP = (const bf16_t*)(p.ws + OFF_KP);
  const bf16_t* V = (const bf16_t*)(p.ws + OFF_V); const bf16_t* G = (const bf16_t*)(p.ws + OFF_G);
  const bf16_t* Y = (const bf16_t*)(p.ws + OFF_Y);
  bf16_t* YR = (bf16_t*)(p.ws + OFF_YRWKV);
  float lg[8], lb[8], rk[8];
#pragma unroll
  for (int j = 0; j < 8; ++j) { lg[j] = p.in[I_LNXG][lane * 8 + j]; lb[j] = p.in[I_LNXB][lane * 8 + j]; rk[j] = p.in[I_RK][lane * 8 + j]; }
  for (int t = wg; t < T_; t += nw) {
    const size_t o = (size_t)t * 512 + lane * 8;
    float y[8], r[8], k[8], v[8], g[8];
    unpack8(*(const uint4*)(Y + o), y); unpack8(*(const uint4*)(R + o), r); unpack8(*(const uint4*)(KP + o), k);
    unpack8(*(const uint4*)(V + o), v); unpack8(*(const uint4*)(G + o), g);
    float s = 0.f, dot = 0.f;
#pragma unroll
    for (int j = 0; j < 8; ++j) { s += y[j]; dot += r[j] * k[j] * rk[j]; }
    const float mu = sum8lanes(s) * (1.f / 64.f);
    dot = sum8lanes(dot);
    float q = 0.f;
#pragma unroll
    for (int j = 0; j < 8; ++j) { y[j] -= mu; q += y[j] * y[j]; }
    const float rs = rsqrtf(sum8lanes(q) * (1.f / 64.f) + 64e-5f);
    uint4 ov; unsigned w[4];
#pragma unroll
    for (int j = 0; j < 4; ++j) {
      const float a = (y[2 * j] * rs * lg[2 * j] + lb[2 * j] + dot * v[2 * j]) * g[2 * j];
      const float c = (y[2 * j + 1] * rs * lg[2 * j + 1] + lb[2 * j + 1] + dot * v[2 * j + 1]) * g[2 * j + 1];
      w[j] = (unsigned)f2bf(a) | ((unsigned)f2bf(c) << 16);
    }
    ov.x = w[0]; ov.y = w[1]; ov.z = w[2]; ov.w = w[3];
    *(uint4*)(YR + o) = ov;
  }
}

DEV void conv_wT(const float* src, int ldsrc, int c0, int K, int N, int Npad, bf16_t* dst, float* lds, int& item0, int gsz, int wv) {
  const int tid = opaque_tid(wv);
  const int nt = Npad / 64, kt = K / 64;
  const int nitems = nt * kt;
  for (int item = ((int)blockIdx.x - item0 % gsz + gsz) % gsz; item < nitems; item += gsz) {
    const int n0 = (item % nt) * 64, k0 = (item / nt) * 64;
    __syncthreads();
    for (int e = tid; e < 4096; e += 256) {
      int kk = e >> 6, nn = e & 63;
      lds[kk * 65 + nn] = (n0 + nn < N) ? src[(size_t)(k0 + kk) * ldsrc + c0 + n0 + nn] : 0.f;
    }
    __syncthreads();
    for (int e = tid; e < 512; e += 256) {
      const int nn = e >> 3, kk = (e & 7) * 8;
      uint4 o;
      o.x = (unsigned)f2bf(lds[kk * 65 + nn]) | ((unsigned)f2bf(lds[(kk + 1) * 65 + nn]) << 16);
      o.y = (unsigned)f2bf(lds[(kk + 2) * 65 + nn]) | ((unsigned)f2bf(lds[(kk + 3) * 65 + nn]) << 16);
      o.z = (unsigned)f2bf(lds[(kk + 4) * 65 + nn]) | ((unsigned)f2bf(lds[(kk + 5) * 65 + nn]) << 16);
      o.w = (unsigned)f2bf(lds[(kk + 6) * 65 + nn]) | ((unsigned)f2bf(lds[(kk + 7) * 65 + nn]) << 16);
      *(uint4*)(dst + (size_t)(n0 + nn) * K + k0 + kk) = o;
    }
  }
  item0 += nitems;
}

typedef __attribute__((ext_vector_type(8))) short bf16x8;
typedef __attribute__((ext_vector_type(16))) float f32x16;
typedef __attribute__((ext_vector_type(4))) unsigned u32x4;

DEV int swz(int row, int c) { return row * 128 + ((c ^ ((row >> 1) & 7)) << 4); }

template <bool ZERO = true>
DEV void mfma_gemm_mainloop(const bf16_t* A, int lda, const bf16_t* Bt, int ldb, int K, int m0, int n0, unsigned char* lds, f32x16 (&acc)[2][2], int wv) {
  const int tid = opaque_tid(wv), lane = tid & 63, wm = wv >> 1, wn = wv & 1;
  const int l31 = lane & 31, lh = lane >> 5;
  if (ZERO) {
#pragma unroll
    for (int i = 0; i < 2; ++i)
#pragma unroll
      for (int j = 0; j < 2; ++j)
#pragma unroll
        for (int r = 0; r < 16; ++r) acc[i][j][r] = 0.f;
  }
  const int KT = K / 64;
  typedef __attribute__((address_space(3))) void* ldsp_t;
  const int prow = lane >> 3, pcp = lane & 7;
  unsigned goffA[4], goffB[4];
#pragma unroll
  for (int j = 0; j < 4; ++j) {
    const int row = 8 * (4 * wv + j) + prow, c = pcp ^ ((row >> 1) & 7);
    goffA[j] = (unsigned)(row * lda + c * 8); goffB[j] = (unsigned)(row * ldb + c * 8);
  }
  const bf16_t* Ab = A + (size_t)m0 * lda; const bf16_t* Bb = Bt + (size_t)n0 * ldb;
#define GEMM_GLDS(buf_, kt_) do { _Pragma("unroll") for (int j = 0; j < 4; ++j) { \
      __builtin_amdgcn_global_load_lds((const void*)(Ab + (kt_) * 64 + goffA[j]), (ldsp_t)(lds + (buf_) * 32768 + (4 * wv + j) * 1024), 16, 0, 0); \
      __builtin_amdgcn_global_load_lds((const void*)(Bb + (kt_) * 64 + goffB[j]), (ldsp_t)(lds + (buf_) * 32768 + 16384 + (4 * wv + j) * 1024), 16, 0, 0); } } while (0)
  __syncthreads();
  GEMM_GLDS(0, 0);
  __builtin_amdgcn_sched_barrier(0);
  asm volatile("s_waitcnt vmcnt(0)" ::: "memory");
  __syncthreads();
  __builtin_amdgcn_sched_barrier(0);
  for (int kt = 0; kt < KT; ++kt) {
    if (kt + 1 < KT) GEMM_GLDS((kt + 1) & 1, kt + 1);
    const unsigned char* as = lds + (kt & 1) * 32768; const unsigned char* bs = as + 16384;
#pragma unroll
    for (int s = 0; s < 4; ++s) {
      bf16x8 af[2], bfr[2];
#pragma unroll
      for (int i = 0; i < 2; ++i) {
        af[i] = *(const bf16x8*)(as + swz(wm * 64 + i * 32 + l31, 2 * s + lh));
        bfr[i] = *(const bf16x8*)(bs + swz(wn * 64 + i * 32 + l31, 2 * s + lh));
      }
#pragma unroll
      for (int i = 0; i < 2; ++i)
#pragma unroll
        for (int j = 0; j < 2; ++j) acc[i][j] = __builtin_amdgcn_mfma_f32_32x32x16_bf16(af[i], bfr[j], acc[i][j], 0, 0, 0);
    }
    __builtin_amdgcn_sched_barrier(0);
    asm volatile("s_waitcnt vmcnt(0)" ::: "memory");
    __syncthreads();
    __builtin_amdgcn_sched_barrier(0);
  }
}

template <class Epi>
DEV void mfma_gemm_tile(const bf16_t* A, int lda, const bf16_t* Bt, int ldb, int K, int m0, int n0, unsigned char* lds, Epi& epi, int wv) {
  const int tid = opaque_tid(wv), lane = tid & 63, wm = wv >> 1, wn = wv & 1;
  const int l31 = lane & 31, lh = lane >> 5;
  f32x16 acc[2][2];
  mfma_gemm_mainloop(A, lda, Bt, ldb, K, m0, n0, lds, acc, wv);
#pragma unroll
  for (int i = 0; i < 2; ++i)
#pragma unroll
    for (int j = 0; j < 2; ++j) {
      const int rb = m0 + wm * 64 + i * 32, cb = n0 + wn * 64 + j * 32;
      if (epi.block(rb, cb, l31, lh, acc[i][j])) continue;
#pragma unroll
      for (int r = 0; r < 16; ++r) {
        epi(rb + (r & 3) + 8 * (r >> 2) + 4 * lh, cb + l31, acc[i][j][r]);
        if ((r & 3) == 3) __builtin_amdgcn_sched_barrier(0);
      }
    }
}

typedef __attribute__((ext_vector_type(4))) float f32x4;
template <bool ZERO = true>
DEV void mfma_gemm_mainloop16(const bf16_t* A, int lda, const bf16_t* Bt, int ldb, int K, int m0, int n0, unsigned char* lds, f32x4 (&acc)[4][4], int wv) {
  const int tid = opaque_tid(wv), lane = tid & 63, wm = wv >> 1, wn = wv & 1;
  const int l15 = lane & 15, lq = lane >> 4;
  if (ZERO) {
#pragma unroll
    for (int i = 0; i < 4; ++i)
#pragma unroll
      for (int j = 0; j < 4; ++j) acc[i][j] = f32x4{0.f, 0.f, 0.f, 0.f};
  }
  const int KT = K / 64;
  typedef __attribute__((address_space(3))) void* ldsp_t;
  const int prow = lane >> 3, pcp = lane & 7;
  unsigned goffA[4], goffB[4];
#pragma unroll
  for (int j = 0; j < 4; ++j) {
    const int row = 8 * (4 * wv + j) + prow, c = pcp ^ ((row >> 1) & 7);
    goffA[j] = (unsigned)(row * lda + c * 8); goffB[j] = (unsigned)(row * ldb + c * 8);
  }
  const bf16_t* Ab = A + (size_t)m0 * lda; const bf16_t* Bb = Bt + (size_t)n0 * ldb;
  __syncthreads();
  GEMM_GLDS(0, 0);
  __builtin_amdgcn_sched_barrier(0);
  asm volatile("s_waitcnt vmcnt(0)" ::: "memory");
  __syncthreads();
  __builtin_amdgcn_sched_barrier(0);
  for (int kt = 0; kt < KT; ++kt) {
    if (kt + 1 < KT) GEMM_GLDS((kt + 1) & 1, kt + 1);
    const unsigned char* as = lds + (kt & 1) * 32768; const unsigned char* bs = as + 16384;
#pragma unroll
    for (int s = 0; s < 2; ++s) {
      bf16x8 af[4], bfr[4];
#pragma unroll
      for (int i = 0; i < 4; ++i) {
        af[i] = *(const bf16x8*)(as + swz(wm * 64 + i * 16 + l15, 4 * s + lq));
        bfr[i] = *(const bf16x8*)(bs + swz(wn * 64 + i * 16 + l15, 4 * s + lq));
      }
#pragma unroll
      for (int i = 0; i < 4; ++i)
#pragma unroll
        for (int j = 0; j < 4; ++j) acc[i][j] = __builtin_amdgcn_mfma_f32_16x16x32_bf16(af[i], bfr[j], acc[i][j], 0, 0, 0);
    }
    __builtin_amdgcn_sched_barrier(0);
    asm volatile("s_waitcnt vmcnt(0)" ::: "memory");
    __syncthreads();
    __builtin_amdgcn_sched_barrier(0);
  }
}

template <class Epi>
DEV void mfma_gemm_tile16(const bf16_t* A, int lda, const bf16_t* Bt, int ldb, int K, int m0, int n0, unsigned char* lds, Epi& epi, int wv) {
  const int tid = opaque_tid(wv), lane = tid & 63, wm = wv >> 1, wn = wv & 1;
  const int l15 = lane & 15, lq = lane >> 4;
  f32x4 acc[4][4];
  mfma_gemm_mainloop16(A, lda, Bt, ldb, K, m0, n0, lds, acc, wv);
#pragma unroll
  for (int i = 0; i < 4; ++i)
#pragma unroll
    for (int j = 0; j < 4; ++j) {
      const int rb = m0 + wm * 64 + i * 16, cb = n0 + wn * 64 + j * 16;
      if (epi.block16(rb, cb, l15, lq, acc[i][j])) continue;
#pragma unroll
      for (int r = 0; r < 4; ++r) epi(rb + 4 * lq + r, cb + l15, acc[i][j][r]);
      __builtin_amdgcn_sched_barrier(0);
    }
}

template <class Epi>
DEV void mfma_gemm16(const bf16_t* A, int lda, const bf16_t* Bt, int ldb, int K, int M, int N, unsigned char* lds, Epi epi, int wv) {
  const int nt = N / 128, mt = M / 128;
  const int grp = blockIdx.x & 7, slot = blockIdx.x >> 3, nslots = gridDim.x >> 3, mg = mt >> 3;
  for (int l = slot; l < mg * nt; l += nslots)
    mfma_gemm_tile16(A, lda, Bt, ldb, K, (grp * mg + l % mg) * 128, (l / mg) * 128, lds, epi, wv);
}

template <class F> struct ElemEpi { F f; DEV bool block(int, int, int, int, const f32x16&) const { return false; } DEV bool block16(int, int, int, int, const f32x4&) const { return false; } DEV void operator()(int t, int n, float v) const { f(t, n, v); } };
template <class F> DEV ElemEpi<F> elem_epi(F f) { return ElemEpi<F>{f}; }

template <class Epi>
DEV void mfma_gemm(const bf16_t* A, int lda, const bf16_t* Bt, int ldb, int K, int M, int N, unsigned char* lds, Epi epi, int wv) {
  const int nt = N / 128, mt = M / 128;
  if ((gridDim.x & 7) == 0 && (mt & 7) == 0) {
    const int grp = blockIdx.x & 7, slot = blockIdx.x >> 3, nslots = gridDim.x >> 3, mg = mt >> 3;
    for (int l = slot; l < mg * nt; l += nslots)
      mfma_gemm_tile(A, lda, Bt, ldb, K, (grp * mg + l % mg) * 128, (l / mg) * 128, lds, epi, wv);
  } else {
    const int nitems = mt * nt;
    for (int item = blockIdx.x; item < nitems; item += gridDim.x)
      mfma_gemm_tile(A, lda, Bt, ldb, K, (item / nt) * 128, (item % nt) * 128, lds, epi, wv);
  }
}

struct ZEpi {
  bf16_t *q, *kvc, *kslc, *kwin, *vslct, *vwint, *rw; float* gate;
  DEV static void rows(bf16_t* base, int ld, int lh, const f32x16& a, float scale) {
#pragma unroll
    for (int r = 0; r < 16; ++r) base[(unsigned)(((r & 3) + 8 * (r >> 2) + 4 * lh) * ld)] = f2bf(a[r] * scale);
  }
  DEV bool block(int rb, int cb, int l31, int lh, const f32x16& a) const {
    if (cb < 512) { rows(q + (unsigned)(rb * 512 + cb + l31), 512, lh, a, 0.125f * 1.4426950408889634f); return true; }
    if (cb < 768) { rows(kvc + (unsigned)(rb * 256 + cb - 512 + l31), 256, lh, a, 1.f); return true; }
    if (cb < 896) { rows(kslc + (unsigned)(rb * 128 + cb - 768 + l31), 128, lh, a, 1.f); return true; }
    if (cb >= 1024 && cb < 1152) { rows(kwin + (unsigned)(rb * 128 + cb - 1024 + l31), 128, lh, a, 1.f); return true; }
    if (cb >= 1312 && cb < 3072) { rows(rw + (unsigned)(rb * RWC + cb - 1304 + l31), RWC, lh, a, 1.f); return true; }
    if (cb >= 3104) return true;
    if (cb == 1280 || cb == 3072) return false;
    bf16_t* dst = (cb < 1024) ? vslct : vwint;
    const int c = cb - ((cb < 1024) ? 896 : 1152) + l31;
    bf16_t* base = dst + (unsigned)((((rb >> 11) * 2 + (c >> 6)) * 64 + (c & 63)) * S_ + (rb & 2047) + 4 * lh);
#pragma unroll
    for (int g4 = 0; g4 < 4; ++g4) {
      ushort4 o; o.x = f2bf(a[4 * g4]); o.y = f2bf(a[4 * g4 + 1]); o.z = f2bf(a[4 * g4 + 2]); o.w = f2bf(a[4 * g4 + 3]);
      *(ushort4*)(base + 8 * g4) = o;
    }
    return true;
  }
  DEV static void rows16(bf16_t* base, int ld, const f32x4& a, float scale) {
#pragma unroll
    for (int r = 0; r < 4; ++r) base[(unsigned)(r * ld)] = f2bf(a[r] * scale);
  }
  DEV bool block16(int rb, int cb, int l15, int lq, const f32x4& a) const {
    const int r0 = rb + 4 * lq;
    if (cb < 512) { rows16(q + (unsigned)(r0 * 512 + cb + l15), 512, a, 0.125f * 1.4426950408889634f); return true; }
    if (cb < 768) { rows16(kvc + (unsigned)(r0 * 256 + cb - 512 + l15), 256, a, 1.f); return true; }
    if (cb < 896) { rows16(kslc + (unsigned)(r0 * 128 + cb - 768 + l15), 128, a, 1.f); return true; }
    if (cb >= 1024 && cb < 1152) { rows16(kwin + (unsigned)(r0 * 128 + cb - 1024 + l15), 128, a, 1.f); return true; }
    if (cb >= 1312 && cb < 3072) { rows16(rw + (unsigned)(r0 * RWC + cb - 1304 + l15), RWC, a, 1.f); return true; }
    if (cb >= 3104) return true;
    if (cb >= 1280 && cb < 1312) return false;
    if (cb >= 3072) return false;
    bf16_t* dst = (cb < 1024) ? vslct : vwint;
    const int c = cb - ((cb < 1024) ? 896 : 1152) + l15;
    ushort4 o; o.x = f2bf(a[0]); o.y = f2bf(a[1]); o.z = f2bf(a[2]); o.w = f2bf(a[3]);
    *(ushort4*)(dst + (unsigned)((((rb >> 11) * 2 + (c >> 6)) * 64 + (c & 63)) * S_ + (r0 & 2047))) = o;
    return true;
  }
  DEV void operator()(int t, int n, float v) const {
    if (n < 512) q[(unsigned)(t * 512 + n)] = f2bf(v * (0.125f * 1.4426950408889634f));
    else if (n < 768) kvc[(unsigned)(t * 256 + (n - 512))] = f2bf(v);
    else if (n < 896) kslc[(unsigned)(t * 128 + (n - 768))] = f2bf(v);
    else if (n < 1024) { int c = n - 896; vslct[(unsigned)((((t >> 11) * 2 + (c >> 6)) * 64 + (c & 63)) * S_ + (t & 2047))] = f2bf(v); }
    else if (n < 1152) kwin[(unsigned)(t * 128 + (n - 1024))] = f2bf(v);
    else if (n < 1280) { int c = n - 1152; vwint[(unsigned)((((t >> 11) * 2 + (c >> 6)) * 64 + (c & 63)) * S_ + (t & 2047))] = f2bf(v); }
    else if (n < 1304) gate[(unsigned)(t * 24 + (n - 1280))] = sigm(v);
    else if (n < NZ) rw[(unsigned)(t * RWC + (n - 1304))] = f2bf(v);
  }
};

DEV void ph_ztail(const Params& p, const ZEpi& e, int wv) {
  if (wv != 0) return;
  const int lane = opaque_tid(wv) & 63, l31 = lane & 31, lh = lane >> 5;
  const bf16_t* HB = (const bf16_t*)(p.ws + OFF_HB); const bf16_t* WT = (const bf16_t*)(p.ws + W_IN) + (size_t)3072 * 1024;
  for (int rb = blockIdx.x; rb < T_ / 32; rb += gridDim.x) {
    const bf16_t* ap = HB + (size_t)(32 * rb + l31) * 1024 + 8 * lh; const bf16_t* bp = WT + (size_t)l31 * 1024 + 8 * lh;
    f32x16 acc;
#pragma unroll
    for (int r = 0; r < 16; ++r) acc[r] = 0.f;
#pragma unroll 8
    for (int ks = 0; ks < 64; ++ks) acc = __builtin_amdgcn_mfma_f32_32x32x16_bf16(*(const bf16x8*)(ap + 16 * ks), *(const bf16x8*)(bp + 16 * ks), acc, 0, 0, 0);
#pragma unroll
    for (int r = 0; r < 16; ++r) e(32 * rb + (r & 3) + 8 * (r >> 2) + 4 * lh, 3072 + l31, acc[r]);
  }
}

DEV void shift8(const uint4& cur, const uint4& prv, const float* mu, float (&o)[8]) {
  float c[8], q[8]; unpack8(cur, c); unpack8(prv, q);
#pragma unroll
  for (int j = 0; j < 8; ++j) o[j] = c[j] + mu[j] * (q[j] - c[j]);
}
DEV uint4 pack8f(const float (&f)[8]) {
  uint4 u;
  u.x = (unsigned)f2bf(f[0]) | ((unsigned)f2bf(f[1]) << 16); u.y = (unsigned)f2bf(f[2]) | ((unsigned)f2bf(f[3]) << 16);
  u.z = (unsigned)f2bf(f[4]) | ((unsigned)f2bf(f[5]) << 16); u.w = (unsigned)f2bf(f[6]) | ((unsigned)f2bf(f[7]) << 16);
  return u;
}
DEV float fast_tanh(float x) { const float e = __expf(2.f * x); return 1.f - 2.f / (e + 1.f); }

DEV void ph_prep2(const Params& p, unsigned char* lds, int wv) {
  const int tid = opaque_tid(wv), lane = tid & 63, w = tid >> 6, l31 = lane & 31, lh = lane >> 5;
  const bf16_t* RW = (const bf16_t*)p.out;
  bf16_t* R = (bf16_t*)(p.ws + OFF_R); bf16_t* OMD = (bf16_t*)(p.ws + OFF_OMD); bf16_t* KP = (bf16_t*)(p.ws + OFF_KP);
  bf16_t* V = (bf16_t*)(p.ws + OFF_V); bf16_t* KB = (bf16_t*)(p.ws + OFF_KB); bf16_t* G = (bf16_t*)(p.ws + OFF_G);
  const bf16_t* W2T = (const bf16_t*)(p.ws + W_LW); const bf16_t* A2T = (const bf16_t*)(p.ws + W_LA); const bf16_t* G2T = (const bf16_t*)(p.ws + W_LG);
  const float* mu = p.in[I_MU];
  float* inv = (float*)(lds + 16384);
  unsigned char* ksm = lds + 20480;
  const uint4 zero4 = make_uint4(0u, 0u, 0u, 0u);
  for (int item = blockIdx.x; item < T_ / 32; item += gridDim.x) {
    const int t0 = item * 32; const bool first = (t0 & 2047) == 0;
    __syncthreads();
    for (int idx = tid; idx < 1024; idx += 256) {
      const int row = idx >> 5, ch = idx & 31;
      const bf16_t* src = RW + (size_t)(t0 + row) * RWC + 1536 + ch * 8;
      const uint4 cur = *(const uint4*)src;
      const uint4 prv = (first && row == 0) ? zero4 : *(const uint4*)(src - RWC);
      float x[8]; shift8(cur, prv, mu + 1536 + ch * 8, x);
      if (ch < 8) {
#pragma unroll
        for (int j = 0; j < 8; ++j) x[j] = fast_tanh(x[j]);
      } else if (ch >= 16) {
#pragma unroll
        for (int j = 0; j < 8; ++j) x[j] = sigm(x[j]);
      }
      *(uint4*)(lds + row * 512 + ((ch ^ (row & 15)) << 4)) = pack8f(x);
    }
#pragma unroll 2
    for (int row = w; row < 32; row += 4) {
      const size_t t = t0 + row;
      const bool nopv = first && row == 0;
      const bf16_t* src = RW + t * RWC + lane * 8;
      const uint4 c0 = *(const uint4*)src, c1 = *(const uint4*)(src + 512), c2 = *(const uint4*)(src + 1024);
      const uint4 p0 = nopv ? zero4 : *(const uint4*)(src - RWC), p1 = nopv ? zero4 : *(const uint4*)(src + 512 - RWC), p2 = nopv ? zero4 : *(const uint4*)(src + 1024 - RWC);
      float x[8];
      shift8(c0, p0, mu + lane * 8, x);
      *(uint4*)(R + t * 512 + lane * 8) = pack8f(x);
      shift8(c2, p2, mu + 1024 + lane * 8, x);
      *(uint4*)(V + t * 512 + lane * 8) = pack8f(x);
      shift8(c1, p1, mu + 512 + lane * 8, x);
      const uint4 kq = pack8f(x);
      *(uint4*)(ksm + row * 1024 + lane * 16) = kq;
      float kr[8]; unpack8(kq, kr);
      float ss = 0.f;
#pragma unroll
      for (int j = 0; j < 8; ++j) { const float q = kr[j] * p.in[I_KK][lane * 8 + j]; ss += q * q; }
      ss = sum8lanes(ss);
      if ((lane & 7) == 0) inv[row * 8 + (lane >> 3)] = 1.f / fmaxf(sqrtf(ss), 1e-12f);
    }
    asm volatile("s_waitcnt vmcnt(0)" ::: "memory");
    __syncthreads();
    {
      constexpr int mb = 0;
      const int arow = l31;
#pragma unroll 1
      for (int nb = 0; nb < 4; ++nb) {
        const int n = 128 * w + 32 * nb + l31;
        {
          f32x16 acc;
#pragma unroll
          for (int r = 0; r < 16; ++r) acc[r] = 0.f;
#pragma unroll
          for (int s = 0; s < 4; ++s) {
            const bf16x8 af = *(const bf16x8*)(lds + arow * 512 + (((2 * s + lh) ^ (arow & 15)) << 4));
            const bf16x8 bfr = *(const bf16x8*)(W2T + (size_t)n * 64 + 16 * s + 8 * lh);
            acc = __builtin_amdgcn_mfma_f32_32x32x16_bf16(af, bfr, acc, 0, 0, 0);
          }
          const float w0 = p.in[I_W0][n];
#pragma unroll
          for (int r = 0; r < 16; ++r) {
            const size_t t = t0 + 32 * mb + (r & 3) + 8 * (r >> 2) + 4 * lh;
            const float nx = -(w0 + acc[r]);
            const float sp = fmaxf(nx, 0.f) + __logf(1.f + __expf(-fabsf(nx)));
            const float e = __expf(-sp - 0.5f);
            OMD[t * 512 + n] = f2bf(1.f - __expf(-e));
          }
        }
        {
          f32x16 acc;
#pragma unroll
          for (int r = 0; r < 16; ++r) acc[r] = 0.f;
#pragma unroll
          for (int s = 0; s < 4; ++s) {
            const bf16x8 af = *(const bf16x8*)(lds + arow * 512 + (((8 + 2 * s + lh) ^ (arow & 15)) << 4));
            const bf16x8 bfr = *(const bf16x8*)(A2T + (size_t)n * 64 + 16 * s + 8 * lh);
            acc = __builtin_amdgcn_mfma_f32_32x32x16_bf16(af, bfr, acc, 0, 0, 0);
          }
          const int h = n >> 6, c = n & 63;
          const float a0 = p.in[I_A0][n], kkw = p.in[I_KK][n], kaw = p.in[I_KA][n];
#pragma unroll
          for (int r = 0; r < 16; ++r) {
            const int lrow = 32 * mb + (r & 3) + 8 * (r >> 2) + 4 * lh;
            const size_t t = t0 + lrow;
            const float a = sigm(a0 + acc[r]);
            const float k = bf2f(*(const bf16_t*)(ksm + lrow * 1024 + n * 2));
            const float kk = k * kkw * inv[lrow * 8 + h];
            KP[t * 512 + n] = f2bf(k * (1.f + (a - 1.f) * kaw));
            KB[(t * 8 + h) * 128 + c] = f2bf(kk);
            KB[(t * 8 + h) * 128 + 64 + c] = f2bf(kk * a);
          }
        }
        {
          f32x16 acc;
#pragma unroll
          for (int r = 0; r < 16; ++r) acc[r] = 0.f;
#pragma unroll
          for (int s = 0; s < 8; ++s) {
            const bf16x8 af = *(const bf16x8*)(lds + arow * 512 + (((16 + 2 * s + lh) ^ (arow & 15)) << 4));
            const bf16x8 bfr = *(const bf16x8*)(G2T + (size_t)n * 128 + 16 * s + 8 * lh);
            acc = __builtin_amdgcn_mfma_f32_32x32x16_bf16(af, bfr, acc, 0, 0, 0);
          }
#pragma unroll
          for (int r = 0; r < 16; ++r) {
            const size_t t = t0 + 32 * mb + (r & 3) + 8 * (r >> 2) + 4 * lh;
            G[t * 512 + n] = f2bf(acc[r]);
          }
        }
      }
    }
  }
}

DEV int swz32(int row, int c) { return row * 64 + ((c ^ ((row >> 2) & 3)) << 4); }
DEV void ph_cmp2(const Params& p, unsigned char* lds, int wv) {
  const int tid = opaque_tid(wv), lane = tid & 63, l31 = lane & 31, lh = lane >> 5;
  const bf16_t* kvc = (const bf16_t*)(p.ws + OFF_KVC);
  bf16_t* KC = (bf16_t*)(p.ws + OFF_KC); bf16_t* VCT = (bf16_t*)(p.ws + OFF_VCT);
  const float* C1 = (const float*)(p.ws + W_C1);
  for (int item = blockIdx.x; item < 128; item += gridDim.x) {
    const int kv = item >> 6, m0 = (item & 63) * 32;
    const bf16_t* W1T = (const bf16_t*)(p.ws + W_C1T) + (size_t)kv * 256 * 2048;
    const bf16_t* W2T = (const bf16_t*)(p.ws + W_C2T) + (size_t)kv * 64 * 256;
    const int am = m0 + l31, abg = am >> 7, ac = am & 127;
    const bf16_t* ap = kvc + ((size_t)(abg >> 1) * S_ + 16 * ac) * 256 + kv * 128 + (abg & 1) * 64 + 8 * lh;
    const bf16_t* bp0 = W1T + (size_t)(lh * 256 + 64 * wv + l31) * 8;
    const bf16_t* bp1 = bp0 + 32 * 8;
    f32x16 acc[2];
#pragma unroll
    for (int r = 0; r < 16; ++r) { acc[0][r] = 0.f; acc[1][r] = 0.f; }
#pragma unroll 8
    for (int ks = 0; ks < 128; ++ks) {
      const bf16x8 af = *(const bf16x8*)(ap + (ks >> 2) * 256 + (ks & 3) * 16);
      const bf16x8 b0 = *(const bf16x8*)(bp0 + (size_t)ks * (2 * 256 * 8));
      const bf16x8 b1 = *(const bf16x8*)(bp1 + (size_t)ks * (2 * 256 * 8));
      acc[0] = __builtin_amdgcn_mfma_f32_32x32x16_bf16(af, b0, acc[0], 0, 0, 0);
      acc[1] = __builtin_amdgcn_mfma_f32_32x32x16_bf16(af, b1, acc[1], 0, 0, 0);
    }
    __syncthreads();
#pragma unroll
    for (int nb = 0; nb < 2; ++nb) {
      const int n = 64 * wv + 32 * nb + l31;
      const float c1 = C1[kv * 256 + n];
#pragma unroll
      for (int r = 0; r < 16; ++r) {
        const int row = (r & 3) + 8 * (r >> 2) + 4 * lh;
        *(bf16_t*)(lds + row * 512 + (((n >> 3) ^ (row & 15)) << 4) + (n & 7) * 2) = f2bf(gelu_tanh(acc[nb][r] + c1));
      }
    }
    __syncthreads();
    if (wv < 2) {
      f32x16 o;
#pragma unroll
      for (int r = 0; r < 16; ++r) o[r] = 0.f;
#pragma unroll
      for (int s = 0; s < 16; ++s) {
        const bf16x8 af = *(const bf16x8*)(lds + l31 * 512 + (((2 * s + lh) ^ (l31 & 15)) << 4));
        const bf16x8 bfr = *(const bf16x8*)(W2T + (size_t)(32 * wv + l31) * 256 + 16 * s + 8 * lh);
        o = __builtin_amdgcn_mfma_f32_32x32x16_bf16(af, bfr, o, 0, 0, 0);
      }
      const int n = 32 * wv + l31;
      const float b2 = p.in[I_CB2][kv * 64 + n];
      if (kv == 0) {
#pragma unroll
        for (int r = 0; r < 16; ++r) { const int m = m0 + (r & 3) + 8 * (r >> 2) + 4 * lh; KC[(size_t)m * 64 + n] = f2bf(o[r] + b2); }
      } else {
#pragma unroll
        for (int g4 = 0; g4 < 4; ++g4) {
          const int m = m0 + 8 * g4 + 4 * lh, bg = m >> 7, c = m & 127;
          ushort4 q; q.x = f2bf(o[4 * g4] + b2); q.y = f2bf(o[4 * g4 + 1] + b2); q.z = f2bf(o[4 * g4 + 2] + b2); q.w = f2bf(o[4 * g4 + 3] + b2);
          *(ushort4*)(VCT + ((size_t)bg * 64 + n) * 128 + c) = q;
        }
      }
    }
  }
}

DEV float dpp_row_sum16(float x) {
  x += __int_as_float(__builtin_amdgcn_update_dpp(0, __float_as_int(x), 0xB1, 0xF, 0xF, true));
  x += __int_as_float(__builtin_amdgcn_update_dpp(0, __float_as_int(x), 0x4E, 0xF, 0xF, true));
  x += __int_as_float(__builtin_amdgcn_update_dpp(0, __float_as_int(x), 0x124, 0xF, 0xF, true));
  x += __int_as_float(__builtin_amdgcn_update_dpp(0, __float_as_int(x), 0x128, 0xF, 0xF, true));
  return x;
}

DEV void ph_scan2(const Params& p, float* lds, int wv) {
  const int tid = opaque_tid(wv);
  const bf16_t* R = (const bf16_t*)(p.ws + OFF_R); const bf16_t* OMD = (const bf16_t*)(p.ws + OFF_OMD); const bf16_t* KP = (const bf16_t*)(p.ws + OFF_KP);
  const bf16_t* V = (const bf16_t*)(p.ws + OFF_V); const bf16_t* KB = (const bf16_t*)(p.ws + OFF_KB);
  bf16_t* Y = (bf16_t*)(p.ws + OFF_Y);
  constexpr int CH = 16;
  const int kpart = tid & 15, rp = tid >> 4, k0 = kpart * 4;
  const int li = tid >> 4, lc4 = (tid & 15) * 4;
  __builtin_amdgcn_s_setprio(3);
  for (int item = blockIdx.x; item < 256; item += gridDim.x) {
    const int bh = item >> 2, vq = item & 3, b = bh >> 3, h = bh & 7;
    const int row0 = vq * 16 + rp;
    float s0 = 0.f, s1 = 0.f, s2 = 0.f, s3 = 0.f;
    ushort4 g0, g1, g2, g3, g4, g5;
#define SC_GLOAD(c0_) do { const size_t t_ = (size_t)b * S_ + (c0_) + li; const size_t o_ = t_ * 512 + h * 64 + lc4; const size_t ob_ = (t_ * 8 + h) * 128 + lc4; \
      g0 = *(const ushort4*)(R + o_); g1 = *(const ushort4*)(OMD + o_); g2 = *(const ushort4*)(KP + o_); g3 = *(const ushort4*)(V + o_); \
      g4 = *(const ushort4*)(KB + ob_); g5 = *(const ushort4*)(KB + ob_ + 64); } while (0)
#define SC_LSTORE(buf_) do { float* d_ = lds + (buf_) * (CH * 384) + li * 384 + lc4; \
      *(float4*)(d_) = make_float4(bf2f(g0.x), bf2f(g0.y), bf2f(g0.z), bf2f(g0.w)); \
      *(float4*)(d_ + 64) = make_float4(1.f - bf2f(g1.x), 1.f - bf2f(g1.y), 1.f - bf2f(g1.z), 1.f - bf2f(g1.w)); \
      *(float4*)(d_ + 128) = make_float4(bf2f(g2.x), bf2f(g2.y), bf2f(g2.z), bf2f(g2.w)); \
      *(float4*)(d_ + 192) = make_float4(bf2f(g3.x), bf2f(g3.y), bf2f(g3.z), bf2f(g3.w)); \
      *(float4*)(d_ + 256) = make_float4(bf2f(g4.x), bf2f(g4.y), bf2f(g4.z), bf2f(g4.w)); \
      *(float4*)(d_ + 320) = make_float4(bf2f(g5.x), bf2f(g5.y), bf2f(g5.z), bf2f(g5.w)); } while (0)
    __syncthreads();
    SC_GLOAD(0); SC_LSTORE(0);
    __syncthreads();
    for (int c = 0; c < S_ / CH; ++c) {
      if (c + 1 < S_ / CH) SC_GLOAD((c + 1) * CH);
      const float* base = lds + (c & 1) * (CH * 384);
      float yk[CH];
      float4 o_r[3], o_d[3], o_k[3], o_q[3], o_b[3]; float o_v[3];
#define SC_LD(slot_, i_) do { const float* tk_ = base + (i_) * 384; o_r[slot_] = *(const float4*)(tk_ + k0); o_d[slot_] = *(const float4*)(tk_ + 64 + k0); \
        o_k[slot_] = *(const float4*)(tk_ + 128 + k0); o_q[slot_] = *(const float4*)(tk_ + 256 + k0); o_b[slot_] = *(const float4*)(tk_ + 320 + k0); o_v[slot_] = tk_[192 + row0]; } while (0)
      SC_LD(0, 0); SC_LD(1, 1);
#pragma unroll
      for (int i = 0; i < CH; ++i) {
        if (i + 2 < CH) SC_LD((i + 2) % 3, i + 2);
        const float4 rr = o_r[i % 3], dd = o_d[i % 3], kp = o_k[i % 3], kk = o_q[i % 3], bb = o_b[i % 3];
        const float vv = o_v[i % 3];
        float sa = (s0 * kk.x + s1 * kk.y) + (s2 * kk.z + s3 * kk.w);
        sa = -dpp_row_sum16(sa);
        s0 = s0 * dd.x + sa * bb.x + vv * kp.x; s1 = s1 * dd.y + sa * bb.y + vv * kp.y; s2 = s2 * dd.z + sa * bb.z + vv * kp.z; s3 = s3 * dd.w + sa * bb.w + vv * kp.w;
        yk[i] = s0 * rr.x + s1 * rr.y + s2 * rr.z + s3 * rr.w;
      }
#pragma unroll
      for (int i = 0; i < 8; ++i) { const bool up = kpart & 8; const float keep = up ? yk[i + 8] : yk[i]; const float send = up ? yk[i] : yk[i + 8];
        yk[i] = keep + __int_as_float(__builtin_amdgcn_update_dpp(0, __float_as_int(send), 0x128, 0xF, 0xF, true)); }
#pragma unroll
      for (int i = 0; i < 4; ++i) { const bool up = kpart & 4; const float keep = up ? yk[i + 4] : yk[i]; const float send = up ? yk[i] : yk[i + 4];
        yk[i] = keep + SWZ_XOR(send, 4); }
#pragma unroll
      for (int i = 0; i < 2; ++i) { const bool up = kpart & 2; const float keep = up ? yk[i + 2] : yk[i]; const float send = up ? yk[i] : yk[i + 2];
        yk[i] = keep + __int_as_float(__builtin_amdgcn_update_dpp(0, __float_as_int(send), 0x4E, 0xF, 0xF, true)); }
      { const bool up = kpart & 1; const float keep = up ? yk[1] : yk[0]; const float send = up ? yk[0] : yk[1];
        yk[0] = keep + __int_as_float(__builtin_amdgcn_update_dpp(0, __float_as_int(send), 0xB1, 0xF, 0xF, true)); }
      {
        const size_t t = (size_t)b * S_ + c * CH + kpart;
        Y[(t * 8 + h) * 64 + row0] = f2bf(yk[0]);
      }
      if (c + 1 < S_ / CH) SC_LSTORE((c + 1) & 1);
      __syncthreads();
    }
  }
  __builtin_amdgcn_s_setprio(0);
}

typedef __attribute__((ext_vector_type(4))) short s16x4;
constexpr float LOG2E = 1.4426950408889634f;

DEV bf16x8 pack8(const f32x16& x, int s) {
  u32x4 q;
  if (s == 0)
    asm volatile("v_cvt_pk_bf16_f32 %0, %4, %5\n\tv_cvt_pk_bf16_f32 %1, %6, %7\n\tv_cvt_pk_bf16_f32 %2, %8, %9\n\tv_cvt_pk_bf16_f32 %3, %10, %11\n\ts_nop 1"
                 : "=&v"(q[0]), "=&v"(q[1]), "=&v"(q[2]), "=&v"(q[3])
                 : "v"(x[0]), "v"(x[1]), "v"(x[2]), "v"(x[3]), "v"(x[4]), "v"(x[5]), "v"(x[6]), "v"(x[7]));
  else
    asm volatile("v_cvt_pk_bf16_f32 %0, %4, %5\n\tv_cvt_pk_bf16_f32 %1, %6, %7\n\tv_cvt_pk_bf16_f32 %2, %8, %9\n\tv_cvt_pk_bf16_f32 %3, %10, %11\n\ts_nop 1"
                 : "=&v"(q[0]), "=&v"(q[1]), "=&v"(q[2]), "=&v"(q[3])
                 : "v"(x[8]), "v"(x[9]), "v"(x[10]), "v"(x[11]), "v"(x[12]), "v"(x[13]), "v"(x[14]), "v"(x[15]));
  return __builtin_bit_cast(bf16x8, q);
}

DEV int vswz(int d, int chunk, int half) { return d * 128 + ((chunk ^ ((d >> 1) & 7)) << 4) + ((half ^ ((d >> 4) & 1)) << 3); }


DEV void ph_nsa_mfma(const Params& p, unsigned char* lds, unsigned* ctr, int wv) {
  const bf16_t* Q = (const bf16_t*)(p.ws + OFF_Q);
  const bf16_t* KC = (const bf16_t*)(p.ws + OFF_KC); const bf16_t* VCT = (const bf16_t*)(p.ws + OFF_VCT);
  const bf16_t* KSLC = (const bf16_t*)(p.ws + OFF_KSLC); const bf16_t* KWIN = (const bf16_t*)(p.ws + OFF_KWIN);
  const bf16_t* VSLCT = (const bf16_t*)(p.ws + OFF_VSLCT); const bf16_t* VWINT = (const bf16_t*)(p.ws + OFF_VWINT);
  const float* GATE = (const float*)(p.ws + OFF_GATE);
  bf16_t* YN = (bf16_t*)(p.ws + OFF_YNSA);
  unsigned char* Kl = lds;
  unsigned char* Vl = lds + 16384;
  float* tb = (float*)(lds + 32768);
  float* impP = (float*)(lds + 34816);
  float* scl = (float*)(lds + 34816 + 16896);
  unsigned* selm = (unsigned*)(lds + 34816 + 16896 + 4224);
  int* sitem = (int*)(lds + 34816 + 16896 + 4224 + 128);
  const int NITEMS = B_ * 2 * 64;
  for (;;) {
    __syncthreads();
    if (opaque_tid(wv) == 0) sitem[0] = (int)atomicAdd(ctr, 1u);
    __syncthreads();
    const int item = sitem[0];
    if (item >= NITEMS) break;
    const int tid = opaque_tid(wv);
    const int lane = tid & 63, hp = tid >> 6, l31 = lane & 31, lh = lane >> 5;
    const int qb = 63 - (item >> 4), g = item & 1, b = (item >> 1) & 7;
    const int bg = b * 2 + g, head = g * 4 + hp;
    const int s0 = qb * 32, cur = s0 >> 6;
    const int sq = s0 + l31;
    const size_t tq = (size_t)b * S_ + sq;
    for (int e = tid; e < 512; e += 256) { int hh = e >> 7, d = e & 127; tb[e] = p.in[I_RELB][T5B[d] * 8 + g * 4 + hh] * LOG2E; }
    bf16x8 qf[4];
#pragma unroll
    for (int s = 0; s < 4; ++s) qf[s] = *(const bf16x8*)(Q + tq * 512 + head * 64 + 16 * s + 8 * lh);
    const float* mytb = tb + hp * 128;
    const int nct = (qb <= 31) ? 1 : 2;
    int wlo = s0 - 511; if (wlo < 0) wlo = 0;
    const int ktlo = wlo >> 6;
    const int nslc = cur + 1, nwin = cur - ktlo + 1;
    const int NT = 2 * nct + nslc + nwin;
#define GET_TILE(ti_, kp_, vp_, ks_, vs_, md_, p0_) do { \
      const int ti__ = (ti_); \
      if (ti__ < 2 * nct) { \
        const int c0 = (ti__ < nct ? ti__ : ti__ - nct) * 64; \
        kp_ = KC + ((size_t)bg * 128 + c0) * 64; ks_ = 64; vp_ = VCT + (size_t)bg * 64 * 128 + c0; vs_ = 128; md_ = ti__ < nct ? 0 : 1; p0_ = c0; \
      } else if (ti__ < 2 * nct + nslc) { \
        const int k0 = (ti__ - 2 * nct) * 64; \
        kp_ = KSLC + ((size_t)b * S_ + k0) * 128 + g * 64; ks_ = 128; vp_ = VSLCT + (size_t)bg * 64 * S_ + k0; vs_ = S_; md_ = 2; p0_ = k0; \
      } else { \
        const int k0 = (ktlo + ti__ - 2 * nct - nslc) * 64; \
        kp_ = KWIN + ((size_t)b * S_ + k0) * 128 + g * 64; ks_ = 128; vp_ = VWINT + (size_t)bg * 64 * S_ + k0; vs_ = S_; md_ = 3; p0_ = k0; \
      } } while (0)
    uint4 rk0, rk1, rv0, rv1;
    const int srow0 = tid >> 3, srow1 = (tid + 256) >> 3, sc = tid & 7;
#define NSA_GLOAD(kp, vp, kstride, vstride) do { \
      rk0 = *(const uint4*)((kp) + (size_t)srow0 * (kstride) + sc * 8); rk1 = *(const uint4*)((kp) + (size_t)srow1 * (kstride) + sc * 8); \
      rv0 = *(const uint4*)((vp) + (size_t)srow0 * (vstride) + sc * 8); rv1 = *(const uint4*)((vp) + (size_t)srow1 * (vstride) + sc * 8); } while (0)
#define NSA_LSTORE(buf) do { \
      *(uint4*)(Kl + (buf) * 8192 + swz(srow0, sc)) = rk0; *(uint4*)(Kl + (buf) * 8192 + swz(srow1, sc)) = rk1; \
      { uint4 v = rv0; if ((srow0 >> 4) & 1) { unsigned tx = v.x, ty = v.y; v.x = v.z; v.y = v.w; v.z = tx; v.w = ty; } \
        *(uint4*)(Vl + (buf) * 8192 + srow0 * 128 + ((sc ^ ((srow0 >> 1) & 7)) << 4)) = v; } \
      { uint4 v = rv1; if ((srow1 >> 4) & 1) { unsigned tx = v.x, ty = v.y; v.x = v.z; v.y = v.w; v.z = tx; v.w = ty; } \
        *(uint4*)(Vl + (buf) * 8192 + srow1 * 128 + ((sc ^ ((srow1 >> 1) & 7)) << 4)) = v; } } while (0)
    f32x16 O[2]; unsigned OUTP[2][8];
#pragma unroll
    for (int r = 0; r < 16; ++r) { O[0][r] = 0.f; O[1][r] = 0.f; }
#pragma unroll
    for (int r = 0; r < 8; ++r) { OUTP[0][r] = 0u; OUTP[1][r] = 0u; }
    float m = NEGF, l = 0.f;
    float invl_cmp = 0.f, m_cmpe = 0.f;
    float carry_prev = 0.f;
    unsigned mymask = 0u;
    const bf16_t *kpn, *vpn; int ksn, vsn, mode, pos0, moden, pos0n;
    GET_TILE(0, kpn, vpn, ksn, vsn, mode, pos0);
    NSA_GLOAD(kpn, vpn, ksn, vsn); NSA_LSTORE(0);
    __syncthreads();
    for (int ti = 0; ti < NT; ++ti) {
      moden = mode; pos0n = pos0;
      if (ti + 1 < NT) { GET_TILE(ti + 1, kpn, vpn, ksn, vsn, moden, pos0n); NSA_GLOAD(kpn, vpn, ksn, vsn); }
      if (ti == nct) {
        const float g0 = GATE[tq * 24 + head * 3];
        const float il = l > 0.f ? 1.f / l : 0.f;
#pragma unroll
        for (int r = 0; r < 8; ++r) {
          OUTP[0][r] = (unsigned)f2bf(g0 * il * O[0][2 * r]) | ((unsigned)f2bf(g0 * il * O[0][2 * r + 1]) << 16);
          OUTP[1][r] = (unsigned)f2bf(g0 * il * O[1][2 * r]) | ((unsigned)f2bf(g0 * il * O[1][2 * r + 1]) << 16);
        }
#pragma unroll
        for (int r = 0; r < 16; ++r) { O[0][r] = 0.f; O[1][r] = 0.f; }
        invl_cmp = il; m_cmpe = (m < -1e29f) ? 0.f : m; carry_prev = 0.f;
      }
      if (ti == 2 * nct) {
        __syncthreads();
        {
          const int q = tid >> 3, jb = (tid & 7) * 4;
#pragma unroll
          for (int jj = 0; jj < 4; ++jj) {
            const int j = jb + jj;
            float imp = impP[(0 * 32 + q) * 33 + j] + impP[(1 * 32 + q) * 33 + j] + impP[(2 * 32 + q) * 33 + j] + impP[(3 * 32 + q) * 33 + j];
            const bool forced = (j == 0) || (j == cur) || (j == cur - 1);
            scl[q * 33 + j] = (j > cur) ? NEGF : imp + (forced ? 1.0e4f : 0.f);
          }
          if (tid < 32) selm[tid] = 0u;
        }
        __syncthreads();
        {
          const int q = tid >> 3, jb = (tid & 7) * 4;
          unsigned bits = 0u;
#pragma unroll
          for (int jj = 0; jj < 4; ++jj) {
            const int j = jb + jj;
            const float sj = scl[q * 33 + j]; int rank = 0;
#pragma unroll 1
            for (int i = 0; i < 32; ++i) { const float si = scl[q * 33 + i]; rank += (si > sj || (si == sj && i < j)) ? 1 : 0; }
            if (rank < 16 && j <= cur) bits |= 1u << j;
          }
          if (bits) atomicOr(&selm[q], bits);
        }
        __syncthreads();
        mymask = selm[l31];
        m = NEGF; l = 0.f;
      }
      if (ti == 2 * nct + nslc) {
        const float g1 = GATE[tq * 24 + head * 3 + 1];
        const float il = l > 0.f ? 1.f / l : 0.f;
#pragma unroll
        for (int r = 0; r < 8; ++r) {
#pragma unroll
          for (int db = 0; db < 2; ++db) {
            const float lo = __uint_as_float(OUTP[db][r] << 16) + g1 * il * O[db][2 * r], hi = __uint_as_float(OUTP[db][r] & 0xffff0000u) + g1 * il * O[db][2 * r + 1];
            OUTP[db][r] = (unsigned)f2bf(lo) | ((unsigned)f2bf(hi) << 16);
          }
        }
#pragma unroll
        for (int r = 0; r < 16; ++r) { O[0][r] = 0.f; O[1][r] = 0.f; }
        m = NEGF; l = 0.f;
      }
      const unsigned char* kb_ = Kl + (ti & 1) * 8192; const unsigned char* vb_ = Vl + (ti & 1) * 8192;
      f32x16 S[2];
#pragma unroll
      for (int r = 0; r < 16; ++r) { S[0][r] = 0.f; S[1][r] = 0.f; }
#pragma unroll
      for (int s = 0; s < 4; ++s) {
        bf16x8 k0 = *(const bf16x8*)(kb_ + swz(l31, 2 * s + lh));
        bf16x8 k1 = *(const bf16x8*)(kb_ + swz(32 + l31, 2 * s + lh));
        S[0] = __builtin_amdgcn_mfma_f32_32x32x16_bf16(k0, qf[s], S[0], 0, 0, 0);
        S[1] = __builtin_amdgcn_mfma_f32_32x32x16_bf16(k1, qf[s], S[1], 0, 0, 0);
      }
      __builtin_amdgcn_sched_barrier(0);
      const int kmul = (mode < 2) ? 16 : 1;
      const int d0 = ((mode < 2) ? (sq - 31 - 16 * pos0) : (sq - pos0)) - kmul * 4 * lh;
      const unsigned selbit = (mode == 2) ? ((mymask >> (pos0 >> 6)) & 1u) : 1u;
      const unsigned dmaxl = selbit ? ((mode == 3) ? 512u : 0x7fffffffu) : 0u;
      float mx = NEGF;
      const int dmin = ((mode < 2) ? (s0 - 31 - 16 * (pos0 + 63)) : (s0 - (pos0 + 63)));
      const int dmaxt = ((mode < 2) ? (s0 + 31 - 31 - 16 * pos0) : (s0 + 31 - pos0));
      const bool fast = (dmin >= 113) && (mode != 3 || dmaxt < 512);
      if (fast) {
        const float cb = mytb[127];
        const bool on = dmaxl != 0u;
#pragma unroll
        for (int kb = 0; kb < 2; ++kb)
#pragma unroll
          for (int r = 0; r < 16; ++r) { const float v = on ? S[kb][r] + cb : NEGF; S[kb][r] = v; mx = fmaxf(mx, v); }
      } else {
#pragma unroll
      for (int kb = 0; kb < 2; ++kb)
#pragma unroll
        for (int r = 0; r < 16; ++r) {
          const int koff = 32 * kb + (r & 3) + 8 * (r >> 2);
          const unsigned dist = (unsigned)(d0 - kmul * koff);
          const unsigned di = dist < 127u ? dist : 127u;
          float bias = mytb[di];
          asm volatile("" : "+v"(bias));
          const float v = (dist < dmaxl) ? S[kb][r] + bias : NEGF;
          S[kb][r] = v;
          mx = fmaxf(mx, v);
        }
      }
      mx = xor32_max(mx);
      if (mode == 1) {
        float lastother = carry_prev;
#pragma unroll
        for (int kb = 0; kb < 2; ++kb)
#pragma unroll
          for (int g4 = 0; g4 < 4; ++g4) {
            float pr[4];
#pragma unroll
            for (int i = 0; i < 4; ++i) pr[i] = __builtin_amdgcn_exp2f(S[kb][g4 * 4 + i] - m_cmpe) * invl_cmp;
            const float own = pr[0] + pr[1] + pr[2] + 0.5f * pr[3];
            const float cr = 0.5f * pr[3];
            const float other = __uint_as_float(xor32_get(__float_as_uint(cr), lh));
            const float tot = own + (lh ? other : lastother);
            lastother = other;
            const int j = (pos0 >> 2) + 8 * kb + 2 * g4 + lh;
            impP[(hp * 32 + l31) * 33 + j] = tot;
          }
        carry_prev = lastother;
      } else {
        const float mn = fmaxf(m, mx);
        const float alpha = __builtin_amdgcn_exp2f(m - mn);
        const float mne = (mn < -1e29f) ? 0.f : mn;
        float rs = 0.f;
#pragma unroll
        for (int kb = 0; kb < 2; ++kb)
#pragma unroll
          for (int r = 0; r < 16; ++r) { const float pr = __builtin_amdgcn_exp2f(S[kb][r] - mne); S[kb][r] = pr; rs += pr; }
        rs = xor32_sum(rs);
        l = l * alpha + rs; m = mn;
#pragma unroll
        for (int r = 0; r < 16; ++r) { O[0][r] *= alpha; O[1][r] *= alpha; }
        __builtin_amdgcn_sched_barrier(0);
#pragma unroll
        for (int kb = 0; kb < 2; ++kb)
#pragma unroll
          for (int s2 = 0; s2 < 2; ++s2) {
            const bf16x8 pk = pack8(S[kb], s2);
            const int ch = 4 * kb + 2 * s2;
#pragma unroll
            for (int db = 0; db < 2; ++db) {
              const int d = 32 * db + l31;
              s16x4 lo = *(const s16x4*)(vb_ + vswz(d, ch, lh));
              s16x4 hi = *(const s16x4*)(vb_ + vswz(d, ch + 1, lh));
              const bf16x8 vf = __builtin_shufflevector(lo, hi, 0, 1, 2, 3, 4, 5, 6, 7);
              O[db] = __builtin_amdgcn_mfma_f32_32x32x16_bf16(vf, pk, O[db], 0, 0, 0);
            }
          }
      }
      if (ti + 1 < NT) NSA_LSTORE((ti + 1) & 1);
      __syncthreads();
      mode = moden; pos0 = pos0n;
    }
    {
      const float g2 = GATE[tq * 24 + head * 3 + 2];
      const float il = l > 0.f ? 1.f / l : 0.f;
#pragma unroll
      for (int db = 0; db < 2; ++db)
#pragma unroll
        for (int g4 = 0; g4 < 4; ++g4) {
          ushort4 o;
          o.x = f2bf(__uint_as_float(OUTP[db][g4 * 2] << 16) + g2 * il * O[db][g4 * 4 + 0]);
          o.y = f2bf(__uint_as_float(OUTP[db][g4 * 2] & 0xffff0000u) + g2 * il * O[db][g4 * 4 + 1]);
          o.z = f2bf(__uint_as_float(OUTP[db][g4 * 2 + 1] << 16) + g2 * il * O[db][g4 * 4 + 2]);
          o.w = f2bf(__uint_as_float(OUTP[db][g4 * 2 + 1] & 0xffff0000u) + g2 * il * O[db][g4 * 4 + 3]);
          *(ushort4*)(YN + tq * 512 + head * 64 + 32 * db + 8 * g4 + 4 * lh) = o;
        }
    }
  }
}

typedef __attribute__((ext_vector_type(2))) float f32x2;
DEV void ph_conv_tables8(const Params& p, int wv) {
  const int tid_ = opaque_tid(wv);
  const int lane = tid_ & 63;
  const int wg = blockIdx.x * 4 + (tid_ >> 6), nw = gridDim.x * 4;
  for (int rr = wg; rr < 2 * 16384; rr += nw) {
    const int tb = rr >> 14, row = rr & 16383;
    const float* src = (tb ? p.in[I_PV] : p.in[I_PU]) + (size_t)row * 1024 + lane * 16;
    float x[16];
#pragma unroll
    for (int i = 0; i < 4; ++i) { const float4 v = ((const float4*)src)[i]; x[4 * i] = v.x; x[4 * i + 1] = v.y; x[4 * i + 2] = v.z; x[4 * i + 3] = v.w; }
    float mx = 0.f;
#pragma unroll
    for (int i = 0; i < 16; ++i) mx = fmaxf(mx, fabsf(x[i]));
    mx = wave_max(mx);
    const float sc = mx > 0.f ? 240.f / mx : 0.f;
    unsigned w[4];
#pragma unroll
    for (int i = 0; i < 4; ++i) {
      int q = __builtin_amdgcn_cvt_pk_fp8_f32(x[4 * i] * sc, x[4 * i + 1] * sc, 0, false);
      q = __builtin_amdgcn_cvt_pk_fp8_f32(x[4 * i + 2] * sc, x[4 * i + 3] * sc, q, true);
      w[i] = (unsigned)q;
    }
    unsigned char* dst = p.ws + (tb ? OFF_V8 : OFF_U8) + (size_t)row * 1024 + lane * 16;
    *(uint4*)dst = make_uint4(w[0], w[1], w[2], w[3]);
    if (lane == 0) ((float*)(p.ws + OFF_SC8))[rr] = mx * (1.f / 240.f);
  }
}

DEV float dot16f8(const uint4& r, const float (&x)[16]) {
  f32x2 a;
  float s;
  a = __builtin_amdgcn_cvt_pk_f32_fp8((int)r.x, false); s = a.x * x[0] + a.y * x[1];
  a = __builtin_amdgcn_cvt_pk_f32_fp8((int)r.x, true);  s += a.x * x[2] + a.y * x[3];
  a = __builtin_amdgcn_cvt_pk_f32_fp8((int)r.y, false); s += a.x * x[4] + a.y * x[5];
  a = __builtin_amdgcn_cvt_pk_f32_fp8((int)r.y, true);  s += a.x * x[6] + a.y * x[7];
  a = __builtin_amdgcn_cvt_pk_f32_fp8((int)r.z, false); s += a.x * x[8] + a.y * x[9];
  a = __builtin_amdgcn_cvt_pk_f32_fp8((int)r.z, true);  s += a.x * x[10] + a.y * x[11];
  a = __builtin_amdgcn_cvt_pk_f32_fp8((int)r.w, false); s += a.x * x[12] + a.y * x[13];
  a = __builtin_amdgcn_cvt_pk_f32_fp8((int)r.w, true);  s += a.x * x[14] + a.y * x[15];
  return s;
}
DEV void axpy16f8(const uint4& r, float w, float (&acc)[16]) {
  f32x2 a;
  a = __builtin_amdgcn_cvt_pk_f32_fp8((int)r.x, false); acc[0] += w * a.x; acc[1] += w * a.y;
  a = __builtin_amdgcn_cvt_pk_f32_fp8((int)r.x, true);  acc[2] += w * a.x; acc[3] += w * a.y;
  a = __builtin_amdgcn_cvt_pk_f32_fp8((int)r.y, false); acc[4] += w * a.x; acc[5] += w * a.y;
  a = __builtin_amdgcn_cvt_pk_f32_fp8((int)r.y, true);  acc[6] += w * a.x; acc[7] += w * a.y;
  a = __builtin_amdgcn_cvt_pk_f32_fp8((int)r.z, false); acc[8] += w * a.x; acc[9] += w * a.y;
  a = __builtin_amdgcn_cvt_pk_f32_fp8((int)r.z, true);  acc[10] += w * a.x; acc[11] += w * a.y;
  a = __builtin_amdgcn_cvt_pk_f32_fp8((int)r.w, false); acc[12] += w * a.x; acc[13] += w * a.y;
  a = __builtin_amdgcn_cvt_pk_f32_fp8((int)r.w, true);  acc[14] += w * a.x; acc[15] += w * a.y;
}

DEV void ph_peer_gather3(const Params& p, int dummy, int wv) {
  const int tid_ = opaque_tid(wv);
  const int lane = tid_ & 63;
  const int wg = blockIdx.x * 4 + (tid_ >> 6), nw = gridDim.x * 4;
  const int* IDX = (const int*)(p.ws + OFF_IDX); const float* GP = (const float*)(p.ws + OFF_GP);
  const unsigned char* U8 = p.ws + OFF_U8; const unsigned char* V8 = p.ws + OFF_V8;
  const float* SCU = (const float*)(p.ws + OFF_SC8); const float* SCV = SCU + 16384;
  float* HW = (float*)(p.ws + OFF_HW);
  for (int t = wg; t < T_; t += nw) {
    const float* irow = p.out + (size_t)t * D_ + lane * 16;
    float x[16];
#pragma unroll
    for (int i = 0; i < 4; ++i) { const float4 v = ((const float4*)irow)[i]; x[4 * i] = v.x; x[4 * i + 1] = v.y; x[4 * i + 2] = v.z; x[4 * i + 3] = v.w; }
    const int id0 = IDX[(size_t)t * 128 + lane], id1 = IDX[(size_t)t * 128 + 64 + lane];
    const float gu0 = GP[(size_t)t * 128 + lane], gu1 = GP[(size_t)t * 128 + 64 + lane];
    const float su0 = SCU[id0], su1 = SCU[id1], sv0 = SCV[id0], sv1 = SCV[id1];
    float hw0 = 0.f, hw1 = 0.f;
    uint4 ca[8];
#pragma unroll
    for (int k = 0; k < 8; ++k) { const int id = __builtin_amdgcn_readlane(id0, k); ca[k] = *(const uint4*)(U8 + (size_t)id * 1024 + lane * 16); }
    for (int gi = 0; gi < 16; ++gi) {
      uint4 na[8];
      if (gi < 15) {
        const int idh = (gi + 1 < 8) ? id0 : id1;
#pragma unroll
        for (int k = 0; k < 8; ++k) { const int id = __builtin_amdgcn_readlane(idh, ((gi + 1) & 7) * 8 + k); na[k] = *(const uint4*)(U8 + (size_t)id * 1024 + lane * 16); }
      }
      float pt[8];
#pragma unroll
      for (int k = 0; k < 8; ++k) pt[k] = dot16f8(ca[k], x);
#pragma unroll
      for (int i = 0; i < 4; ++i) { const bool up = lane & 4; const float keep = up ? pt[i + 4] : pt[i]; const float send = up ? pt[i] : pt[i + 4]; pt[i] = keep + SWZ_XOR(send, 4); }
#pragma unroll
      for (int i = 0; i < 2; ++i) { const bool up = lane & 2; const float keep = up ? pt[i + 2] : pt[i]; const float send = up ? pt[i] : pt[i + 2]; pt[i] = keep + SWZ_XOR(send, 2); }
      { const bool up = lane & 1; const float keep = up ? pt[1] : pt[0]; const float send = up ? pt[0] : pt[1]; pt[0] = keep + SWZ_XOR(send, 1); }
      float tot = pt[0];
      tot += SWZ_XOR(tot, 8); tot += SWZ_XOR(tot, 16); tot = xor32_sum(tot);
      if ((lane >> 3) == (gi & 7)) { if (gi < 8) hw0 = gu0 * gelu_tanh(tot * su0) * sv0; else hw1 = gu1 * gelu_tanh(tot * su1) * sv1; }
      if (gi < 15) {
#pragma unroll
        for (int k = 0; k < 8; ++k) ca[k] = na[k];
      }
    }
    HW[(size_t)t * 128 + lane] = gu0 * gelu_tanh(hw0 * su0) * sv0; HW[(size_t)t * 128 + 64 + lane] = gu1 * gelu_tanh(hw1 * su1) * sv1;
  }
  for (int t = wg; t < T_; t += nw) {
    const int id0 = IDX[(size_t)t * 128 + lane], id1 = IDX[(size_t)t * 128 + 64 + lane];
    const float hw0 = HW[(size_t)t * 128 + lane], hw1 = HW[(size_t)t * 128 + 64 + lane];
    float acc[16];
#pragma unroll
    for (int i = 0; i < 16; ++i) acc[i] = 0.f;
    {
      uint4 ca[8];
#pragma unroll
      for (int k = 0; k < 8; ++k) { const int id = __builtin_amdgcn_readlane(id0, k); ca[k] = *(const uint4*)(V8 + (size_t)id * 1024 + lane * 16); }
      for (int gi = 0; gi < 16; ++gi) {
        uint4 na[8];
        if (gi < 15) {
          const int idh = (gi + 1 < 8) ? id0 : id1;
#pragma unroll
          for (int k = 0; k < 8; ++k) { const int id = __builtin_amdgcn_readlane(idh, ((gi + 1) & 7) * 8 + k); na[k] = *(const uint4*)(V8 + (size_t)id * 1024 + lane * 16); }
        }
        const float hwh = (gi < 8) ? hw0 : hw1;
#pragma unroll
        for (int k = 0; k < 8; ++k) {
          const float w = __int_as_float(__builtin_amdgcn_readlane(__float_as_int(hwh), (gi & 7) * 8 + k));
          axpy16f8(ca[k], w, acc);
        }
        if (gi < 15) {
#pragma unroll
          for (int k = 0; k < 8; ++k) ca[k] = na[k];
        }
      }
    }
    const float* irow = p.out + (size_t)t * D_ + lane * 16;
    float x[16];
#pragma unroll
    for (int i = 0; i < 4; ++i) { const float4 v = ((const float4*)irow)[i]; x[4 * i] = v.x; x[4 * i + 1] = v.y; x[4 * i + 2] = v.z; x[4 * i + 3] = v.w; }
    float* orow = dummy ? (float*)(p.ws + OFF_KVC) + (size_t)(t & 8191) * D_ + lane * 16 : p.out + (size_t)t * D_ + lane * 16;
    float sum = 0.f;
#pragma unroll
    for (int i = 0; i < 16; ++i) { x[i] = ALPHA * x[i] + acc[i]; sum += x[i]; }
    const float mu = wave_sum(sum) * (1.f / D_);
    float vs = 0.f;
#pragma unroll
    for (int i = 0; i < 16; ++i) { x[i] -= mu; vs += x[i] * x[i]; }
    const float rs = rsqrtf(wave_sum(vs) * (1.f / D_) + 1e-5f);
    const float4* gg = (const float4*)(p.in[I_LNFG] + lane * 16); const float4* bb = (const float4*)(p.in[I_LNFB] + lane * 16);
#pragma unroll
    for (int i = 0; i < 4; ++i) {
      float4 g4 = gg[i], b4 = bb[i];
      ((float4*)orow)[i] = make_float4(x[4 * i] * rs * g4.x + b4.x, x[4 * i + 1] * rs * g4.y + b4.y, x[4 * i + 2] * rs * g4.z + b4.z, x[4 * i + 3] * rs * g4.w + b4.w);
    }
  }
}

typedef __attribute__((ext_vector_type(16))) float f32x16v;
typedef __attribute__((ext_vector_type(32))) float f32x32v;
typedef __attribute__((ext_vector_type(6))) unsigned u32x6v;
DEV float half_max(float v) { v = fmaxf(v, SWZ_XOR(v, 1)); v = fmaxf(v, SWZ_XOR(v, 2)); v = fmaxf(v, SWZ_XOR(v, 4)); v = fmaxf(v, SWZ_XOR(v, 8)); v = fmaxf(v, SWZ_XOR(v, 16)); return v; }
DEV float half_sum(float v) { v += SWZ_XOR(v, 1); v += SWZ_XOR(v, 2); v += SWZ_XOR(v, 4); v += SWZ_XOR(v, 8); v += SWZ_XOR(v, 16); return v; }
DEV void ph_conv_tables6(const Params& p, int wv) {
  const int tid_ = opaque_tid(wv);
  const int lane = tid_ & 63, l31 = lane & 31, lh = lane >> 5;
  const int wg = blockIdx.x * 4 + (tid_ >> 6), nw = gridDim.x * 4;
  for (int rp = wg; rp < 16384; rp += nw) {
    const int rr = 2 * rp + lh, tb = rr >> 14, row = rr & 16383;
    const float* src = (tb ? p.in[I_PV] : p.in[I_PU]) + (size_t)row * 1024 + l31 * 32;
    f32x16v a, b;
    float mx = 0.f;
#pragma unroll
    for (int i = 0; i < 8; ++i) { const float4 v = ((const float4*)src)[i]; a[2 * i] = v.x; b[2 * i] = v.y; a[2 * i + 1] = v.z; b[2 * i + 1] = v.w; }
#pragma unroll
    for (int i = 0; i < 16; ++i) mx = fmaxf(mx, fmaxf(fabsf(a[i]), fabsf(b[i])));
    mx = half_max(mx);
    const float sc = mx > 0.f ? 7.5f / mx : 0.f;
#pragma unroll
    for (int i = 0; i < 16; ++i) { a[i] *= sc; b[i] *= sc; }
    const u32x6v w = __builtin_amdgcn_cvt_scalef32_2xpk16_fp6_f32(a, b, 1.0f);
    unsigned char* dst = p.ws + (tb ? OFF_V6 : OFF_U6) + (size_t)row * 768 + l31 * 8;
    *(uint2*)dst = make_uint2(w[0], w[1]); *(uint2*)(dst + 256) = make_uint2(w[2], w[3]); *(uint2*)(dst + 512) = make_uint2(w[4], w[5]);
    if (l31 == 0) ((float*)(p.ws + OFF_SC8))[rr] = mx * (1.f / 7.5f);
  }
}

DEV u32x6v ld24(const unsigned char* ptr) {
  const uint2 a = *(const uint2*)ptr, b = *(const uint2*)(ptr + 256), c = *(const uint2*)(ptr + 512);
  u32x6v w; w[0] = a.x; w[1] = a.y; w[2] = b.x; w[3] = b.y; w[4] = c.x; w[5] = c.y; return w;
}
DEV void ph_peer_gather6(const Params& p, int dummy, int wv) {
  const int tid_ = opaque_tid(wv);
  const int lane = tid_ & 63, l31 = lane & 31, lh = lane >> 5;
  const int wg = blockIdx.x * 4 + wv, nw = gridDim.x * 4;
  const int* IDX = (const int*)(p.ws + OFF_IDX); const float* GP = (const float*)(p.ws + OFF_GP);
  const unsigned char* U6 = p.ws + OFF_U6; const unsigned char* V6 = p.ws + OFF_V6;
  const float* SCU = (const float*)(p.ws + OFF_SC8); const float* SCV = SCU + 16384;
  float* HW = (float*)(p.ws + OFF_HW);
  for (int t = wg; t < T_; t += nw) {
    float x[32];
    {
      const float4* irow = (const float4*)(p.out + (size_t)t * D_ + l31 * 32);
#pragma unroll
      for (int i = 0; i < 8; ++i) { const float4 v = irow[i]; x[4 * i] = v.x; x[4 * i + 1] = v.y; x[4 * i + 2] = v.z; x[4 * i + 3] = v.w; }
    }
    const int id0 = IDX[(size_t)t * 128 + lane], id1 = IDX[(size_t)t * 128 + 64 + lane];
    const float gu0 = GP[(size_t)t * 128 + lane], gu1 = GP[(size_t)t * 128 + 64 + lane];
    const float su0 = SCU[id0], su1 = SCU[id1], sv0 = SCV[id0], sv1 = SCV[id1];
    float hw0 = 0.f, hw1 = 0.f;
    u32x6v ca[4];
#pragma unroll
    for (int q = 0; q < 4; ++q) { const int ida = __builtin_amdgcn_readlane(id0, 2 * q), idb = __builtin_amdgcn_readlane(id0, 2 * q + 1); ca[q] = ld24(U6 + (size_t)(lh ? idb : ida) * 768 + l31 * 8); }
    for (int gi = 0; gi < 16; ++gi) {
      u32x6v na[4];
      if (gi < 15) {
        const int idh = (gi + 1 < 8) ? id0 : id1;
#pragma unroll
        for (int q = 0; q < 4; ++q) {
          const int ida = __builtin_amdgcn_readlane(idh, ((gi + 1) & 7) * 8 + 2 * q), idb = __builtin_amdgcn_readlane(idh, ((gi + 1) & 7) * 8 + 2 * q + 1);
          na[q] = ld24(U6 + (size_t)(lh ? idb : ida) * 768 + l31 * 8);
        }
      }
      float pt[4];
#pragma unroll
      for (int q = 0; q < 4; ++q) {
        const f32x32v r = __builtin_amdgcn_cvt_scalef32_pk32_f32_fp6(ca[q], 1.0f);
        float s0 = 0.f, s1 = 0.f, s2 = 0.f, s3 = 0.f;
#pragma unroll
        for (int j = 0; j < 32; j += 4) { s0 += r[j] * x[j]; s1 += r[j + 1] * x[j + 1]; s2 += r[j + 2] * x[j + 2]; s3 += r[j + 3] * x[j + 3]; }
        pt[q] = (s0 + s1) + (s2 + s3);
      }
#pragma unroll
      for (int i = 0; i < 2; ++i) { const bool up = lane & 2; const float keep = up ? pt[i + 2] : pt[i]; const float send = up ? pt[i] : pt[i + 2]; pt[i] = keep + SWZ_XOR(send, 2); }
      { const bool up = lane & 1; const float keep = up ? pt[1] : pt[0]; const float send = up ? pt[0] : pt[1]; pt[0] = keep + SWZ_XOR(send, 1); }
      float tot = pt[0];
      tot += SWZ_XOR(tot, 4); tot += SWZ_XOR(tot, 8); tot += SWZ_XOR(tot, 16);
      const int srcl = ((lane & 1) << 5) | ((lane & 7) >> 1);
      const float mine = __int_as_float(__builtin_amdgcn_ds_bpermute(srcl << 2, __float_as_int(tot)));
      if ((lane >> 3) == (gi & 7)) { if (gi < 8) hw0 = mine; else hw1 = mine; }
      if (gi < 15) {
#pragma unroll
        for (int q = 0; q < 4; ++q) ca[q] = na[q];
      }
    }
    HW[(size_t)t * 128 + lane] = gu0 * gelu_tanh(hw0 * su0) * sv0; HW[(size_t)t * 128 + 64 + lane] = gu1 * gelu_tanh(hw1 * su1) * sv1;
  }
  for (int t = wg; t < T_; t += nw) {
    const int id0 = IDX[(size_t)t * 128 + lane], id1 = IDX[(size_t)t * 128 + 64 + lane];
    const float hw0 = HW[(size_t)t * 128 + lane], hw1 = HW[(size_t)t * 128 + 64 + lane];
    float acc[32];
#pragma unroll
    for (int j = 0; j < 32; ++j) acc[j] = 0.f;
    {
      u32x6v ca[4];
#pragma unroll
      for (int q = 0; q < 4; ++q) { const int ida = __builtin_amdgcn_readlane(id0, 2 * q), idb = __builtin_amdgcn_readlane(id0, 2 * q + 1); ca[q] = ld24(V6 + (size_t)(lh ? idb : ida) * 768 + l31 * 8); }
      for (int gi = 0; gi < 16; ++gi) {
        u32x6v na[4];
        if (gi < 15) {
          const int idh = (gi + 1 < 8) ? id0 : id1;
#pragma unroll
          for (int q = 0; q < 4; ++q) {
            const int ida = __builtin_amdgcn_readlane(idh, ((gi + 1) & 7) * 8 + 2 * q), idb = __builtin_amdgcn_readlane(idh, ((gi + 1) & 7) * 8 + 2 * q + 1);
            na[q] = ld24(V6 + (size_t)(lh ? idb : ida) * 768 + l31 * 8);
          }
        }
        const float hwh = (gi < 8) ? hw0 : hw1;
#pragma unroll
        for (int q = 0; q < 4; ++q) {
          const float wa = __int_as_float(__builtin_amdgcn_readlane(__float_as_int(hwh), (gi & 7) * 8 + 2 * q));
          const float wb = __int_as_float(__builtin_amdgcn_readlane(__float_as_int(hwh), (gi & 7) * 8 + 2 * q + 1));
          const float w = lh ? wb : wa;
          const f32x32v r = __builtin_amdgcn_cvt_scalef32_pk32_f32_fp6(ca[q], 1.0f);
#pragma unroll
          for (int j = 0; j < 32; ++j) acc[j] += w * r[j];
        }
        if (gi < 15) {
#pragma unroll
          for (int q = 0; q < 4; ++q) ca[q] = na[q];
        }
      }
    }
    const float4* irow = (const float4*)(p.out + (size_t)t * D_ + l31 * 32);
    float y[32]; float sum = 0.f;
#pragma unroll
    for (int i = 0; i < 8; ++i) {
      const float4 v = irow[i];
      y[4 * i] = ALPHA * v.x + xor32_sum(acc[4 * i]); y[4 * i + 1] = ALPHA * v.y + xor32_sum(acc[4 * i + 1]);
      y[4 * i + 2] = ALPHA * v.z + xor32_sum(acc[4 * i + 2]); y[4 * i + 3] = ALPHA * v.w + xor32_sum(acc[4 * i + 3]);
      sum += y[4 * i] + y[4 * i + 1] + y[4 * i + 2] + y[4 * i + 3];
    }
    const float mu = half_sum(sum) * (1.f / D_);
    float vs = 0.f;
#pragma unroll
    for (int j = 0; j < 32; ++j) { y[j] -= mu; vs += y[j] * y[j]; }
    const float rs = rsqrtf(half_sum(vs) * (1.f / D_) + 1e-5f);
    float* orow = (dummy ? (float*)(p.ws + OFF_KVC) + (size_t)(t & 8191) * D_ : p.out + (size_t)t * D_) + l31 * 32;
    const float4* gg = (const float4*)(p.in[I_LNFG] + l31 * 32); const float4* bb = (const float4*)(p.in[I_LNFB] + l31 * 32);
#pragma unroll
    for (int i = 0; i < 8; ++i) {
      if ((i >> 2) == lh) {
        const float4 g4 = gg[i], b4 = bb[i];
        ((float4*)orow)[i] = make_float4(y[4 * i] * rs * g4.x + b4.x, y[4 * i + 1] * rs * g4.y + b4.y, y[4 * i + 2] * rs * g4.z + b4.z, y[4 * i + 3] * rs * g4.w + b4.w);
      }
    }
  }
}

DEV unsigned f2key(float f) { unsigned u = __float_as_uint(f); return u ^ ((unsigned)((int)u >> 31) | 0x80000000u); }
DEV float key2f(unsigned k) { return __uint_as_float((k & 0x80000000u) ? (k ^ 0x80000000u) : ~k); }
DEV void sort16_desc(unsigned (&v)[16]) {
#pragma unroll
  for (int k = 2; k <= 16; k <<= 1) {
#pragma unroll
    for (int j = k >> 1; j > 0; j >>= 1) {
#pragma unroll
      for (int i = 0; i < 16; ++i) {
        const int l = i ^ j;
        if (l > i) {
          const bool desc = ((i & k) == 0);
          const unsigned a = v[i], b = v[l];
          const unsigned hi = a > b ? a : b, lo = a > b ? b : a;
          v[i] = desc ? hi : lo; v[l] = desc ? lo : hi;
        }
      }
    }
  }
}
DEV void merge16_desc(unsigned (&a)[16], const unsigned (&b)[16]) {
#pragma unroll
  for (int i = 0; i < 16; ++i) { const unsigned x = a[i], y = b[15 - i]; a[i] = x > y ? x : y; }
#pragma unroll
  for (int j = 8; j > 0; j >>= 1) {
#pragma unroll
    for (int i = 0; i < 16; ++i) {
      const int l = i ^ j;
      if (l > i) { const unsigned x = a[i], y = a[l]; a[i] = x > y ? x : y; a[l] = x > y ? y : x; }
    }
  }
}


template <int pp>
DEV void qtopk_half(const unsigned char* lds, const bf16_t* SK, int h, int trow, int l31, int lh, unsigned* lists) {
  bf16x8 qf[4];
#pragma unroll
  for (int s = 0; s < 4; ++s) qf[s] = *(const bf16x8*)(lds + trow * 256 + (((pp * 8 + 2 * s + lh) ^ (trow & 15)) << 4));
  unsigned best[16];
#pragma unroll
  for (int i = 0; i < 16; ++i) best[i] = 0u;
#pragma unroll 1
  for (int nb = 0; nb < 4; ++nb) {
    f32x16 S;
#pragma unroll
    for (int r = 0; r < 16; ++r) S[r] = 0.f;
#pragma unroll
    for (int s = 0; s < 4; ++s) {
      const bf16x8 kf = *(const bf16x8*)(SK + ((size_t)((h * 2 + pp) * 128 + 32 * nb + l31)) * 64 + 16 * s + 8 * lh);
      S = __builtin_amdgcn_mfma_f32_32x32x16_bf16(kf, qf[s], S, 0, 0, 0);
    }
    unsigned blk[16];
#pragma unroll
    for (int r = 0; r < 16; ++r) {
      const unsigned n = 32 * nb + (r & 3) + 8 * (r >> 2) + 4 * lh;
      blk[r] = (f2key(S[r]) & ~127u) | n;
    }
    sort16_desc(blk);
    merge16_desc(best, blk);
  }
  unsigned other[16];
#pragma unroll
  for (int i = 0; i < 16; ++i) other[i] = xor32_get(best[i], lh);
  merge16_desc(best, other);
  if (lh == pp) {
#pragma unroll
    for (int i = 0; i < 16; ++i) lists[trow * 32 + pp * 16 + i] = best[i];
  }
}

DEV void ph_peer_qtopk(const Params& p, unsigned char* lds, int wv) {
  const int tid = opaque_tid(wv), lane = tid & 63, w = tid >> 6, wm = w >> 1, wn = w & 1, l31 = lane & 31, lh = lane >> 5;
  const bf16_t* XB = (const bf16_t*)(p.ws + OFF_HB);
  const bf16_t* WQ = (const bf16_t*)(p.ws + W_Q);
  const bf16_t* SK = (const bf16_t*)(p.ws + W_SK);
  int* IDX = (int*)(p.ws + OFF_IDX); float* GP = (float*)(p.ws + OFF_GP);
  unsigned* lists = (unsigned*)(lds + 32768);
  const int nitems = (T_ / 128) * 8;
  for (int item = blockIdx.x; item < nitems; item += gridDim.x) {
    const int m0 = (item >> 3) * 128, h = item & 7;
    f32x4 acc[4][4];
    mfma_gemm_mainloop16(XB, 1024, WQ, 1024, 1024, m0, h * 128, lds, acc, wv);
    {
      const int l15 = lane & 15, lq = lane >> 4;
#pragma unroll
      for (int i = 0; i < 4; ++i)
#pragma unroll
        for (int j = 0; j < 4; ++j)
#pragma unroll
          for (int r = 0; r < 4; ++r) {
            const int row = wm * 64 + i * 16 + 4 * lq + r, col = wn * 64 + j * 16 + l15;
            *(bf16_t*)(lds + row * 256 + ((((col >> 3) ^ (row & 15))) << 4) + (col & 7) * 2) = f2bf(acc[i][j][r]);
          }
    }
    __syncthreads();
    const int trow = 32 * w + l31;
    qtopk_half<0>(lds, SK, h, trow, l31, lh, lists);
    qtopk_half<1>(lds, SK, h, trow, l31, lh, lists);
    float f1[16], f2v[16];
#pragma unroll
    for (int i = 0; i < 16; ++i) { f1[i] = key2f(lists[trow * 32 + i] & ~127u); f2v[i] = key2f(lists[trow * 32 + 16 + i] & ~127u); }
    unsigned cd[4][16];
    cd[0][0] = (f2key(f1[0] + f2v[0]) & ~255u) | 0u;
    cd[0][1] = (f2key(f1[0] + f2v[1]) & ~255u) | 1u;
    cd[0][2] = (f2key(f1[0] + f2v[2]) & ~255u) | 2u;
    cd[0][3] = (f2key(f1[0] + f2v[3]) & ~255u) | 3u;
    cd[0][4] = (f2key(f1[0] + f2v[4]) & ~255u) | 4u;
    cd[0][5] = (f2key(f1[0] + f2v[5]) & ~255u) | 5u;
    cd[0][6] = (f2key(f1[0] + f2v[6]) & ~255u) | 6u;
    cd[0][7] = (f2key(f1[0] + f2v[7]) & ~255u) | 7u;
    cd[0][8] = (f2key(f1[0] + f2v[8]) & ~255u) | 8u;
    cd[0][9] = (f2key(f1[0] + f2v[9]) & ~255u) | 9u;
    cd[0][10] = (f2key(f1[0] + f2v[10]) & ~255u) | 10u;
    cd[0][11] = (f2key(f1[0] + f2v[11]) & ~255u) | 11u;
    cd[0][12] = (f2key(f1[0] + f2v[12]) & ~255u) | 12u;
    cd[0][13] = (f2key(f1[0] + f2v[13]) & ~255u) | 13u;
    cd[0][14] = (f2key(f1[0] + f2v[14]) & ~255u) | 14u;
    cd[0][15] = (f2key(f1[0] + f2v[15]) & ~255u) | 15u;
    cd[1][0] = (f2key(f1[1] + f2v[0]) & ~255u) | 16u;
    cd[1][1] = (f2key(f1[1] + f2v[1]) & ~255u) | 17u;
    cd[1][2] = (f2key(f1[1] + f2v[2]) & ~255u) | 18u;
    cd[1][3] = (f2key(f1[1] + f2v[3]) & ~255u) | 19u;
    cd[1][4] = (f2key(f1[1] + f2v[4]) & ~255u) | 20u;
    cd[1][5] = (f2key(f1[1] + f2v[5]) & ~255u) | 21u;
    cd[1][6] = (f2key(f1[1] + f2v[6]) & ~255u) | 22u;
    cd[1][7] = (f2key(f1[1] + f2v[7]) & ~255u) | 23u;
    cd[1][8] = (f2key(f1[2] + f2v[0]) & ~255u) | 32u;
    cd[1][9] = (f2key(f1[2] + f2v[1]) & ~255u) | 33u;
    cd[1][10] = (f2key(f1[2] + f2v[2]) & ~255u) | 34u;
    cd[1][11] = (f2key(f1[2] + f2v[3]) & ~255u) | 35u;
    cd[1][12] = (f2key(f1[2] + f2v[4]) & ~255u) | 36u;
    cd[1][13] = (f2key(f1[3] + f2v[0]) & ~255u) | 48u;
    cd[1][14] = (f2key(f1[3] + f2v[1]) & ~255u) | 49u;
    cd[1][15] = (f2key(f1[3] + f2v[2]) & ~255u) | 50u;
    cd[2][0] = (f2key(f1[3] + f2v[3]) & ~255u) | 51u;
    cd[2][1] = (f2key(f1[4] + f2v[0]) & ~255u) | 64u;
    cd[2][2] = (f2key(f1[4] + f2v[1]) & ~255u) | 65u;
    cd[2][3] = (f2key(f1[4] + f2v[2]) & ~255u) | 66u;
    cd[2][4] = (f2key(f1[5] + f2v[0]) & ~255u) | 80u;
    cd[2][5] = (f2key(f1[5] + f2v[1]) & ~255u) | 81u;
    cd[2][6] = (f2key(f1[6] + f2v[0]) & ~255u) | 96u;
    cd[2][7] = (f2key(f1[6] + f2v[1]) & ~255u) | 97u;
    cd[2][8] = (f2key(f1[7] + f2v[0]) & ~255u) | 112u;
    cd[2][9] = (f2key(f1[7] + f2v[1]) & ~255u) | 113u;
    cd[2][10] = (f2key(f1[8] + f2v[0]) & ~255u) | 128u;
    cd[2][11] = (f2key(f1[9] + f2v[0]) & ~255u) | 144u;
    cd[2][12] = (f2key(f1[10] + f2v[0]) & ~255u) | 160u;
    cd[2][13] = (f2key(f1[11] + f2v[0]) & ~255u) | 176u;
    cd[2][14] = (f2key(f1[12] + f2v[0]) & ~255u) | 192u;
    cd[2][15] = (f2key(f1[13] + f2v[0]) & ~255u) | 208u;
    cd[3][0] = (f2key(f1[14] + f2v[0]) & ~255u) | 224u;
    cd[3][1] = (f2key(f1[15] + f2v[0]) & ~255u) | 240u;
    cd[3][2] = 0u;
    cd[3][3] = 0u;
    cd[3][4] = 0u;
    cd[3][5] = 0u;
    cd[3][6] = 0u;
    cd[3][7] = 0u;
    cd[3][8] = 0u;
    cd[3][9] = 0u;
    cd[3][10] = 0u;
    cd[3][11] = 0u;
    cd[3][12] = 0u;
    cd[3][13] = 0u;
    cd[3][14] = 0u;
    cd[3][15] = 0u;
#pragma unroll
    for (int q = 0; q < 4; ++q) sort16_desc(cd[q]);
    merge16_desc(cd[0], cd[1]); merge16_desc(cd[2], cd[3]); merge16_desc(cd[0], cd[2]);
    float ev[16]; float sm = 0.f;
    const float mx = key2f(cd[0][0] & ~255u);
#pragma unroll
    for (int i = 0; i < 16; ++i) { ev[i] = __expf(key2f(cd[0][i] & ~255u) - mx); sm += ev[i]; }
    const float inv = 1.f / sm;
    const size_t ob = (size_t)(m0 + trow) * 128 + h * 16;
#pragma unroll
    for (int i = 0; i < 16; ++i) {
      if ((i >> 3) == lh) {
        const unsigned code = cd[0][i] & 255u;
        const unsigned i1 = lists[trow * 32 + (code >> 4)] & 127u, i2 = lists[trow * 32 + 16 + (code & 15u)] & 127u;
        IDX[ob + i] = (int)(i1 * 128u + i2);
        GP[ob + i] = ev[i] * inv;
      }
    }
    __syncthreads();
  }
}

DEV void ph_merge2(const Params& p, unsigned char* lds, int wv) {
  const bf16_t* GS = (const bf16_t*)p.out; bf16_t* M = (bf16_t*)(p.ws + OFF_M);
  const bf16_t* YN = (const bf16_t*)(p.ws + OFF_YNSA); const bf16_t* YR = (const bf16_t*)(p.ws + OFF_YRWKV);
  const bf16_t* WN = (const bf16_t*)(p.ws + W_N); const bf16_t* WR = (const bf16_t*)(p.ws + W_R);
  for (int item = blockIdx.x; item < (T_ / 128) * 8; item += gridDim.x) {
    const int m0 = (item >> 3) * 128, n0 = (item & 7) * 128;
    f32x4 acc[4][4];
    mfma_gemm_mainloop16<true>(YN, 512, WN, 512, 512, m0, n0, lds, acc, wv);
    const int tid = opaque_tid(wv), lane = tid & 63, w = tid >> 6, wm = w >> 1, wn = w & 1, l15 = lane & 15, lq = lane >> 4;
#pragma unroll
    for (int i = 0; i < 4; ++i)
#pragma unroll
      for (int j = 0; j < 4; ++j) {
#pragma unroll
        for (int r = 0; r < 4; ++r) {
          const unsigned t = m0 + wm * 64 + i * 16 + 4 * lq + r, n = n0 + wn * 64 + j * 16 + l15;
          const float g1 = bf2f(GS[t * 2048 + n]), g2 = bf2f(GS[t * 2048 + 1024 + n]);
          acc[i][j][r] *= g1 / fmaxf(g2, 1e-30f);
        }
      }
    mfma_gemm_mainloop16<false>(YR, 512, WR, 512, 512, m0, n0, lds, acc, wv);
#pragma unroll
    for (int i = 0; i < 4; ++i)
#pragma unroll
      for (int j = 0; j < 4; ++j) {
#pragma unroll
        for (int r = 0; r < 4; ++r) {
          const unsigned t = m0 + wm * 64 + i * 16 + 4 * lq + r, n = n0 + wn * 64 + j * 16 + l15;
          M[t * 1024 + n] = f2bf(fmaxf(bf2f(GS[t * 2048 + 1024 + n]), 1e-30f) * acc[i][j][r]);
        }
        __builtin_amdgcn_sched_barrier(0);
      }
  }
}

#define XB_TMO      128
#define XB_XCNT(j)  (256  + 64 * (j))
#define XB_XSUB(j)  (1280 + 64 * (j))
#define XB_XGEN(j)  (2304 + 64 * (j))
#define XB_TOP      3328
#define XB_TOPGEN   3392
#define XCD_BAR_WORDS 3456
#define XB_SPIN_CAP (1u << 22)
#define LAS __attribute__((address_space(3)))
DEV unsigned xb_ld(unsigned* p) { return __hip_atomic_load(p, __ATOMIC_RELAXED, __HIP_MEMORY_SCOPE_AGENT); }
DEV unsigned xb_add(unsigned* p, unsigned v) { return __hip_atomic_fetch_add(p, v, __ATOMIC_RELAXED, __HIP_MEMORY_SCOPE_AGENT); }
DEV unsigned xb_xcc_id() { return (unsigned)__builtin_amdgcn_s_getreg((3 << 11) | 20) & 0xFu; }
#define XB_SPIN(cond, bar) do { unsigned _sp = 0; while (cond) { __builtin_amdgcn_s_sleep(1); \
    if ((++_sp & 255u) == 0u) { if (xb_ld(&(bar)[XB_TMO])) break; if (_sp > XB_SPIN_CAP) { atomicAdd(&(bar)[XB_TMO], 1u); break; } } } } while (0)
struct XcdBarrier { unsigned* bar; unsigned x; volatile LAS unsigned* st; int wv; };
DEV XcdBarrier xcd_barrier_post(unsigned* bar, volatile LAS unsigned* st) {
  XcdBarrier b; b.bar = bar; b.x = xb_xcc_id(); b.st = st;
  if (threadIdx.x == 0) (void)xb_add(&bar[XB_XCNT(b.x)], 1u);
  return b;
}
DEV void xcd_barrier_complete(unsigned* bar, unsigned x, unsigned& nloc, unsigned& nx) {
  const unsigned G = gridDim.x * gridDim.y * gridDim.z;
  unsigned sum, cnt, mine, sp = 0u;
  for (;;) {
    sum = 0u; cnt = 0u; mine = 0u;
#pragma unroll
    for (unsigned j = 0; j < 16; ++j) { const unsigned c = xb_ld(&bar[XB_XCNT(j)]); sum += c; cnt += (c > 0u) ? 1u : 0u; mine = (j == x) ? c : mine; }
    if (sum == G) break;
    __builtin_amdgcn_s_sleep(1);
    if ((++sp & 255u) == 0u) { if (xb_ld(&bar[XB_TMO])) break; if (sp > XB_SPIN_CAP) { atomicAdd(&bar[XB_TMO], 1u); break; } }
  }
  nloc = mine > 0u ? mine : 1u; nx = cnt > 0u ? cnt : 1u;
}
DEV void xcd_barrier(const XcdBarrier& b) {
  asm volatile("s_waitcnt vmcnt(0)" ::: "memory");
  __syncthreads();
  if (opaque_tid(b.wv) == 0) {
    unsigned* bar = b.bar;
    __builtin_amdgcn_s_waitcnt(0);
    unsigned nloc = b.st[0], nx = b.st[1];
    if (nloc == 0u) { xcd_barrier_complete(bar, b.x, nloc, nx); b.st[0] = nloc; b.st[1] = nx; }
    const unsigned old = xb_add(&bar[XB_XSUB(b.x)], 1u);
    const unsigned gen = old / nloc;
    if (old + 1u == (gen + 1u) * nloc) {
      __builtin_amdgcn_fence(__ATOMIC_RELEASE, "agent");
      asm volatile("s_waitcnt vmcnt(0)" ::: "memory");
      const unsigned og = xb_add(&bar[XB_TOP], 1u);
      const unsigned tg = og / nx;
      if (og + 1u == (tg + 1u) * nx) xb_add(&bar[XB_TOPGEN], 1u);
      else XB_SPIN(xb_ld(&bar[XB_TOPGEN]) == tg, bar);
      __builtin_amdgcn_fence(__ATOMIC_ACQUIRE, "agent");
      xb_add(&bar[XB_XGEN(b.x)], 1u);
      asm volatile("s_waitcnt vmcnt(0)" ::: "memory");
    } else {
      XB_SPIN(xb_ld(&bar[XB_XGEN(b.x)]) == gen, bar);
      __builtin_amdgcn_fence(__ATOMIC_ACQUIRE, "agent");
      asm volatile("s_waitcnt vmcnt(0)" ::: "memory");
    }
  }
  __syncthreads();
}

#define REP_Z 1
#define REP_CMP 1
#define REP_PREP 1
#define REP_NSA 1
#define REP_SCAN 1
#define REP_POSTGS 1
#define REP_QTOPK 1
#define REP_GATHER 1
#define REP_P0 1
#define REP_BAR 0
#define REP_P7 1
#define REP_POST 1
#define REP_MERGE 1
#define REP_OUT 1
__global__ void __launch_bounds__(256, 2) mega(Params p) {
  cg::grid_group grid = cg::this_grid();
  const int wv = __builtin_amdgcn_readfirstlane((int)(threadIdx.x >> 6));
  __shared__ __attribute__((aligned(16))) float lds[16384 + 4];
  unsigned char* ldsb = (unsigned char*)lds;
  bf16_t* HB = (bf16_t*)(p.ws + OFF_HB);
  unsigned* ctl = (unsigned*)(p.ws + OFF_CTL);
  if (threadIdx.x < 4) lds[16384 + threadIdx.x] = 0.f;
  __syncthreads();
  XcdBarrier xb = xcd_barrier_post((unsigned*)(p.ws + OFF_BAR), (volatile LAS unsigned*)(lds + 16384)); xb.wv = wv;
  for (int rep = 0; rep < REP_P0; ++rep) {
  ph_ln_wave(p.in[I_X], p.in[I_LNIN_G], p.in[I_LNIN_B], nullptr, HB, wv);
  {
    int it0 = 0; const int gsz = gridDim.x;
    conv_wT(p.in[I_WIN], DIN, 0, 1024, NZ, 3200, (bf16_t*)(p.ws + W_IN), lds, it0, gsz, wv);
    conv_wT(p.in[I_WIN], DIN, C_MG, 1024, 2048, 2048, (bf16_t*)(p.ws + W_G), lds, it0, gsz, wv);
    conv_wT(p.in[I_WON], 1024, 0, 512, 1024, 1024, (bf16_t*)(p.ws + W_N), lds, it0, gsz, wv);
    conv_wT(p.in[I_WOR], 1024, 0, 512, 1024, 1024, (bf16_t*)(p.ws + W_R), lds, it0, gsz, wv);
    conv_wT(p.in[I_WOUT], 1024, 0, 1024, 1024, 1024, (bf16_t*)(p.ws + W_OUT), lds, it0, gsz, wv);
    conv_wT(p.in[I_PWQ], 1024, 0, 1024, 1024, 1024, (bf16_t*)(p.ws + W_Q), lds, it0, gsz, wv);
    conv_wT(p.in[I_W2], 512, 0, 64, 512, 512, (bf16_t*)(p.ws + W_LW), lds, it0, gsz, wv);
    conv_wT(p.in[I_A2], 512, 0, 64, 512, 512, (bf16_t*)(p.ws + W_LA), lds, it0, gsz, wv);
    conv_wT(p.in[I_G2], 512, 0, 128, 512, 512, (bf16_t*)(p.ws + W_LG), lds, it0, gsz, wv);
    {
      bf16_t* W1C = (bf16_t*)(p.ws + W_C1T);
      for (int i = blockIdx.x * 256 + opaque_tid(wv); i < 2 * 256 * 256; i += gsz * 256) {
        const int n = i & 255, kc = (i >> 8) & 255, kv = i >> 16;
        const float* src = p.in[I_CW1] + ((size_t)kv * 2048 + kc * 8) * 256 + n;
        float f[8];
#pragma unroll
        for (int j = 0; j < 8; ++j) f[j] = src[j * 256];
        *(uint4*)(W1C + (size_t)i * 8) = pack8f(f);
      }
    }
    conv_wT(p.in[I_CW2], 64, 0, 256, 64, 64, (bf16_t*)(p.ws + W_C2T), lds, it0, gsz, wv);
    conv_wT(p.in[I_CW2] + 256 * 64, 64, 0, 256, 64, 64, (bf16_t*)(p.ws + W_C2T) + 64 * 256, lds, it0, gsz, wv);
    {
      float* C1 = (float*)(p.ws + W_C1);
      const int ln = opaque_tid(wv) & 63;
      for (int o = blockIdx.x * 4 + wv; o < 512; o += gsz * 4) {
        const int kv = o >> 8, n = o & 255;
        float a = 0.f;
#pragma unroll 16
        for (int e = ln; e < 2048; e += 64) a += p.in[I_CPOS][kv * 2048 + e] * p.in[I_CW1][((size_t)kv * 2048 + e) * 256 + n];
        a = wave_sum(a);
        if (ln == 0) C1[o] = a + p.in[I_CB1][o];
      }
    }
    { bf16_t* SK = (bf16_t*)(p.ws + W_SK); for (int i = blockIdx.x * 256 + opaque_tid(wv); i < 8 * 2 * 128 * 64; i += gsz * 256) SK[i] = f2bf(p.in[I_PSK][i]); }
  }
  }
  if (p.ws == nullptr) grid.sync();
  xcd_barrier(xb);
  {
    ZEpi e{(bf16_t*)(p.ws + OFF_Q), (bf16_t*)(p.ws + OFF_KVC), (bf16_t*)(p.ws + OFF_KSLC), (bf16_t*)(p.ws + OFF_KWIN),
           (bf16_t*)(p.ws + OFF_VSLCT), (bf16_t*)(p.ws + OFF_VWINT), (bf16_t*)p.out, (float*)(p.ws + OFF_GATE)};
    for (int rep = 0; rep < REP_Z; ++rep) { mfma_gemm16(HB, 1024, (const bf16_t*)(p.ws + W_IN), 1024, 1024, T_, 3072, ldsb, e, wv); ph_ztail(p, e, wv); }
  }
  xcd_barrier(xb);
  for (int rep = 0; rep < REP_CMP; ++rep) ph_cmp2(p, ldsb, wv);
  for (int rep = 0; rep < REP_PREP; ++rep) ph_prep2(p, ldsb, wv);
  xcd_barrier(xb);
  for (int rep = 0; rep < REP_SCAN; ++rep) ph_scan2(p, lds, wv);
  for (int rep = 0; rep < REP_NSA; ++rep) ph_nsa_mfma(p, ldsb, ctl + rep, wv);
  xcd_barrier(xb);
  for (int rep = 0; rep < REP_POST; ++rep) ph_post_wave(p, wv);
  {
    bf16_t* GS = (bf16_t*)p.out;
    auto e = elem_epi([=](int t, int n, float v) { GS[(unsigned)(t * 2048 + n)] = f2bf(sigm(v)); });
    for (int rep = 0; rep < REP_POSTGS; ++rep) mfma_gemm16(HB, 1024, (const bf16_t*)(p.ws + W_G), 1024, 1024, T_, 2048, ldsb, e, wv);
  }
  xcd_barrier(xb);
  for (int rep = 0; rep < REP_MERGE; ++rep) ph_merge2(p, ldsb, wv);
  xcd_barrier(xb);
  {
    float* Y1 = p.out;
    auto e = elem_epi([=](int t, int n, float v) { Y1[(unsigned)(t * 1024 + n)] = ALPHA * bf2f(HB[(unsigned)(t * 1024 + n)]) + v; });
    for (int rep = 0; rep < REP_OUT; ++rep) mfma_gemm16((const bf16_t*)(p.ws + OFF_M), 1024, (const bf16_t*)(p.ws + W_OUT), 1024, 1024, T_, 1024, ldsb, e, wv);
  }
  xcd_barrier(xb);
  for (int rep = REP_P7 - 1; rep >= 0; --rep) {
    if (rep) ph_ln_wave(p.out, p.in[I_LNMG], p.in[I_LNMB], nullptr, (bf16_t*)(p.ws + OFF_KVC), wv);
    else ph_ln_wave(p.out, p.in[I_LNMG], p.in[I_LNMB], p.out, HB, wv);
    ph_conv_tables6(p, wv);
  }
  xcd_barrier(xb);
  for (int rep = 0; rep < REP_BAR; ++rep) xcd_barrier(xb);
  for (int rep = 0; rep < REP_QTOPK; ++rep) ph_peer_qtopk(p, ldsb, wv);
  xcd_barrier(xb);
  for (int rep = REP_GATHER - 1; rep >= 0; --rep) ph_peer_gather6(p, rep, wv);
}

extern "C" void kernel_launch(void* const* d_in, const int* in_sizes, int n_in, void* d_out, int out_size, void* d_ws, size_t ws_size, hipStream_t stream) {
  static int grid_blocks = 0;
  if (!grid_blocks) {
    int dev = 0, cus = 0, per_cu = 0;
    hipGetDevice(&dev);
    hipDeviceGetAttribute(&cus, hipDeviceAttributeMultiprocessorCount, dev);
    hipOccupancyMaxActiveBlocksPerMultiprocessor(&per_cu, mega, 256, 0);
    if (per_cu > 4) per_cu = 4;
    if (per_cu < 1) per_cu = 1;
    grid_blocks = cus * per_cu;
  }
  Params p{};
  for (int i = 0; i < 32; ++i) p.in[i] = (const float*)d_in[i];
  p.out = (float*)d_out;
  p.ws = (unsigned char*)d_ws;
  hipMemsetAsync((char*)d_ws + OFF_BAR, 0, 16384, stream);
  void* args[] = {&p};
  hipError_t e = hipLaunchCooperativeKernel((void*)mega, dim3(grid_blocks), dim3(256), args, 0, stream);
  if (e != hipSuccess) fprintf(stderr, "cooperative launch failed: %s (grid %d)\n", hipGetErrorString(e), grid_blocks);
}
```

```cpp
#include <hip/hip_runtime.h>
#include <hip/hip_cooperative_groups.h>
#include <cstdio>
namespace cg = cooperative_groups;

typedef unsigned short bf16_t;
#define DEV __device__ __forceinline__

constexpr int B_ = 8, S_ = 2048, T_ = B_ * S_, D_ = 1024;
constexpr int DIN = 5144;
constexpr int NZ = 3096;
constexpr int C_MG = 3096;
constexpr int RWC = 1792;
constexpr float ALPHA = 1.189207115002721f;
constexpr float NEGF = -1e30f;

enum { I_X = 0, I_LNIN_G, I_LNIN_B, I_RELB, I_WIN, I_MU, I_CPOS, I_CW1, I_CB1, I_CW2, I_CB2, I_W0, I_W2, I_A0, I_A2, I_G2,
       I_KK, I_KA, I_RK, I_LNXG, I_LNXB, I_WON, I_WOR, I_WOUT, I_LNMG, I_LNMB, I_PWQ, I_PSK, I_PU, I_PV, I_LNFG, I_LNFB };

constexpr size_t MiB = 1ull << 20;
constexpr size_t OFF_HB = 0;
constexpr size_t OFF_Q = OFF_HB + 32 * MiB;
constexpr size_t OFF_KVC = OFF_Q + 16 * MiB;
constexpr size_t OFF_KSLC = OFF_KVC + 8 * MiB;
constexpr size_t OFF_KWIN = OFF_KSLC + 4 * MiB;
constexpr size_t OFF_VSLCT = OFF_KWIN + 4 * MiB;
constexpr size_t OFF_VWINT = OFF_VSLCT + 4 * MiB;
constexpr size_t OFF_GATE = OFF_VWINT + 4 * MiB;
constexpr size_t OFF_KC = OFF_GATE + 1536 * 1024;
constexpr size_t OFF_VCT = OFF_KC + 256 * 1024;
constexpr size_t OFF_YNSA = OFF_VCT + 256 * 1024;
constexpr size_t OFF_YRWKV = OFF_YNSA + 16 * MiB;
constexpr size_t OFF_WTS = OFF_YRWKV + 16 * MiB;
constexpr size_t OFF_SCAN = OFF_WTS + 20 * MiB;
constexpr size_t OFF_R = OFF_SCAN;
constexpr size_t OFF_OMD = OFF_R + 16 * MiB;
constexpr size_t OFF_KP = OFF_OMD + 16 * MiB;
constexpr size_t OFF_V = OFF_KP + 16 * MiB;
constexpr size_t OFF_KB = OFF_V + 16 * MiB;
constexpr size_t OFF_G = OFF_KB + 32 * MiB;
constexpr size_t OFF_END = OFF_G + 16 * MiB;
constexpr size_t OFF_Y = OFF_END;
constexpr size_t W_IN = OFF_WTS;
constexpr size_t W_G = W_IN + 3200 * 1024 * 2;
constexpr size_t W_N = W_G + 2048 * 1024 * 2;
constexpr size_t W_R = W_N + 1024 * 512 * 2;
constexpr size_t W_OUT = W_R + 1024 * 512 * 2;
constexpr size_t W_Q = W_OUT + 1024 * 1024 * 2;
constexpr size_t W_SK = W_Q + 1024 * 1024 * 2;
constexpr size_t W_LW = W_SK + 8 * 2 * 128 * 64 * 2;
constexpr size_t W_LA = W_LW + 512 * 64 * 2;
constexpr size_t W_LG = W_LA + 512 * 64 * 2;
constexpr size_t W_C1T = W_LG + 512 * 128 * 2;
constexpr size_t W_C2T = W_C1T + 2 * 256 * 2048 * 2;
constexpr size_t W_C1 = W_C2T + 2 * 64 * 256 * 2;
constexpr size_t W_END = W_C1 + 2 * 256 * 4;
constexpr size_t OFF_BAR = OFF_WTS + 19 * MiB + 512 * 1024;
static_assert(W_END <= OFF_BAR, "weights region");
constexpr size_t OFF_CTL = OFF_BAR + 14336;
constexpr size_t OFF_MF = OFF_SCAN + 32 * MiB;
constexpr size_t OFF_M = OFF_SCAN;
constexpr size_t OFF_QP = OFF_SCAN;
constexpr size_t OFF_U16 = OFF_SCAN + 32 * MiB;
constexpr size_t OFF_V16 = OFF_SCAN + 64 * MiB;
constexpr size_t OFF_U8 = OFF_SCAN + 32 * MiB;
constexpr size_t OFF_V8 = OFF_SCAN + 48 * MiB;
constexpr size_t OFF_SC8 = OFF_SCAN + 64 * MiB;
constexpr size_t OFF_U6 = OFF_SCAN + 32 * MiB;
constexpr size_t OFF_V6 = OFF_SCAN + 48 * MiB;
constexpr size_t OFF_HW = OFF_SCAN + 72 * MiB;
constexpr size_t OFF_IDX = OFF_Q;
constexpr size_t OFF_GP = OFF_Q + 8 * MiB;

struct Params {
  const float* in[32];
  float* out;
  unsigned char* ws;
};

__device__ const unsigned char T5B[128] = {
  0, 1, 2, 3, 4, 5, 6, 7, 8, 9, 10, 11, 12, 13, 14, 15, 16, 16, 16, 17, 17, 18, 18, 18, 19, 19, 19, 20, 20, 20, 20, 21, 21, 21, 21,
  22, 22, 22, 22, 22, 23, 23, 23, 23, 23, 23, 24, 24, 24, 24, 24, 24, 25, 25, 25, 25, 25, 25, 25, 26, 26, 26, 26, 26, 26, 26, 26,
  27, 27, 27, 27, 27, 27, 27, 27, 27, 27, 28, 28, 28, 28, 28, 28, 28, 28, 28, 28, 29, 29, 29, 29, 29, 29, 29, 29, 29, 29, 29, 29,
  30, 30, 30, 30, 30, 30, 30, 30, 30, 30, 30, 30, 30, 30, 31, 31, 31, 31, 31, 31, 31, 31, 31, 31, 31, 31, 31, 31, 31};

DEV int opaque_tid(int wv) { int l; asm volatile("v_mbcnt_lo_u32_b32 %0, -1, 0\n\tv_mbcnt_hi_u32_b32 %0, -1, %0" : "=v"(l)); return wv * 64 + l; }
DEV float bf2f(bf16_t v) { return __uint_as_float(((unsigned)v) << 16); }
DEV bf16_t f2bf(float f) { unsigned u = __float_as_uint(f); u += 0x7fffu + ((u >> 16) & 1u); return (bf16_t)(u >> 16); }
DEV float sigm(float x) { return 1.f / (1.f + __expf(-x)); }
DEV float gelu_tanh(float x) { float u = 0.7978845608028654f * (x + 0.044715f * x * x * x); return 0.5f * x * (1.f + tanhf(u)); }
#define SWZ_XOR(v, K) __int_as_float(__builtin_amdgcn_ds_swizzle(__float_as_int(v), ((K) << 10) | 0x1F))
DEV float xor32_sum(float v) { auto r = __builtin_amdgcn_permlane32_swap(__float_as_uint(v), __float_as_uint(v), false, false); return __uint_as_float(r[0]) + __uint_as_float(r[1]); }
DEV float xor32_max(float v) { auto r = __builtin_amdgcn_permlane32_swap(__float_as_uint(v), __float_as_uint(v), false, false); return fmaxf(__uint_as_float(r[0]), __uint_as_float(r[1])); }
DEV unsigned xor32_get(unsigned v, int lh) { auto r = __builtin_amdgcn_permlane32_swap(v, v, false, false); return lh ? r[0] : r[1]; }
DEV float wave_sum(float v) { v += SWZ_XOR(v, 1); v += SWZ_XOR(v, 2); v += SWZ_XOR(v, 4); v += SWZ_XOR(v, 8); v += SWZ_XOR(v, 16); return xor32_sum(v); }
DEV float wave_max(float v) { v = fmaxf(v, SWZ_XOR(v, 1)); v = fmaxf(v, SWZ_XOR(v, 2)); v = fmaxf(v, SWZ_XOR(v, 4)); v = fmaxf(v, SWZ_XOR(v, 8)); v = fmaxf(v, SWZ_XOR(v, 16)); return xor32_max(v); }
DEV int t5bucket(int dist) { return T5B[dist > 127 ? 127 : dist]; }

DEV void ph_ln_wave(const float* in, const float* g, const float* b, float* of, bf16_t* ob, int wv) {
  const int tid_ = opaque_tid(wv);
  const int lane = tid_ & 63;
  const int wg = blockIdx.x * 4 + (tid_ >> 6), nw = gridDim.x * 4;
  float4 gg[4], bb[4];
#pragma unroll
  for (int i = 0; i < 4; ++i) { gg[i] = ((const float4*)g)[lane + 64 * i]; bb[i] = ((const float4*)b)[lane + 64 * i]; }
  for (int t = wg; t < T_; t += nw) {
    float4 v[4]; float s = 0.f;
#pragma unroll
    for (int i = 0; i < 4; ++i) { v[i] = ((const float4*)(in + (size_t)t * D_))[lane + 64 * i]; s += v[i].x + v[i].y + v[i].z + v[i].w; }
    const float mu = wave_sum(s) * (1.f / D_);
    float q = 0.f;
#pragma unroll
    for (int i = 0; i < 4; ++i) { v[i].x -= mu; v[i].y -= mu; v[i].z -= mu; v[i].w -= mu; q += v[i].x * v[i].x + v[i].y * v[i].y + v[i].z * v[i].z + v[i].w * v[i].w; }
    const float rs = rsqrtf(wave_sum(q) * (1.f / D_) + 1e-5f);
#pragma unroll
    for (int i = 0; i < 4; ++i) {
      float4 o = make_float4(v[i].x * rs * gg[i].x + bb[i].x, v[i].y * rs * gg[i].y + bb[i].y, v[i].z * rs * gg[i].z + bb[i].z, v[i].w * rs * gg[i].w + bb[i].w);
      if (of) ((float4*)(of + (size_t)t * D_))[lane + 64 * i] = o;
      if (ob) { ushort4 h; h.x = f2bf(o.x); h.y = f2bf(o.y); h.z = f2bf(o.z); h.w = f2bf(o.w); ((ushort4*)(ob + (size_t)t * D_))[lane + 64 * i] = h; }
    }
  }
}

DEV void unpack8(const uint4& u, float (&f)[8]) {
  f[0] = __uint_as_float(u.x << 16); f[1] = __uint_as_float(u.x & 0xffff0000u); f[2] = __uint_as_float(u.y << 16); f[3] = __uint_as_float(u.y & 0xffff0000u);
  f[4] = __uint_as_float(u.z << 16); f[5] = __uint_as_float(u.z & 0xffff0000u); f[6] = __uint_as_float(u.w << 16); f[7] = __uint_as_float(u.w & 0xffff0000u);
}
DEV float sum8lanes(float v) { v += SWZ_XOR(v, 1); v += SWZ_XOR(v, 2); v += SWZ_XOR(v, 4); return v; }
DEV void ph_post_wave(const Params& p, int wv) {
  const int tid_ = opaque_tid(wv);
  const int lane = tid_ & 63;
  const int wg = blockIdx.x * 4 + (tid_ >> 6), nw = gridDim.x * 4;
  const bf16_t* R = (const bf16_t*)(p.ws + OFF_R); const bf16_t* KP = (const bf16_t*)(p.ws + OFF_KP);
  const bf16_t* V = (const bf16_t*)(p.ws + OFF_V); const bf16_t* G = (const bf16_t*)(p.ws + OFF_G);
  const bf16_t* Y = (const bf16_t*)(p.ws + OFF_Y);
  bf16_t* YR = (bf16_t*)(p.ws + OFF_YRWKV);
  float lg[8], lb[8], rk[8];
#pragma unroll
  for (int j = 0; j < 8; ++j) { lg[j] = p.in[I_LNXG][lane * 8 + j]; lb[j] = p.in[I_LNXB][lane * 8 + j]; rk[j] = p.in[I_RK][lane * 8 + j]; }
  for (int t = wg; t < T_; t += nw) {
    const size_t o = (size_t)t * 512 + lane * 8;
    float y[8], r[8], k[8], v[8], g[8];
    unpack8(*(const uint4*)(Y + o), y); unpack8(*(const uint4*)(R + o), r); unpack8(*(const uint4*)(KP + o), k);
    unpack8(*(const uint4*)(V + o), v); unpack8(*(const uint4*)(G + o), g);
    float s = 0.f, dot = 0.f;
#pragma unroll
    for (int j = 0; j < 8; ++j) { s += y[j]; dot += r[j] * k[j] * rk[j]; }
    const float mu = sum8lanes(s) * (1.f / 64.f);
    dot = sum8lanes(dot);
    float q = 0.f;
#pragma unroll
    for (int j = 0; j < 8; ++j) { y[j] -= mu; q += y[j] * y[j]; }
    const float rs = rsqrtf(sum8lanes(q) * (1.f / 64.f) + 64e-5f);
    uint4 ov; unsigned w[4];
#pragma unroll
    for (int j = 0; j < 4; ++j) {
      const float a = (y[2 * j] * rs * lg[2 * j] + lb[2 * j] + dot * v[2 * j]) * g[2 * j];
      const float c = (y[2 * j + 1] * rs * lg[2 * j + 1] + lb[2 * j + 1] + dot * v[2 * j + 1]) * g[2 * j + 1];
      w[j] = (unsigned)f2bf(a) | ((unsigned)f2bf(c) << 16);
    }
    ov.x = w[0]; ov.y = w[1]; ov.z = w[2]; ov.w = w[3];
    *(uint4*)(YR + o) = ov;
  }
}

DEV void conv_wT(const float* src, int ldsrc, int c0, int K, int N, int Npad, bf16_t* dst, float* lds, int& item0, int gsz, int wv) {
  const int tid = opaque_tid(wv);
  const int nt = Npad / 64, kt = K / 64;
  const int nitems = nt * kt;
  for (int item = ((int)blockIdx.x - item0 % gsz + gsz) % gsz; item < nitems; item += gsz) {
    const int n0 = (item % nt) * 64, k0 = (item / nt) * 64;
    __syncthreads();
    for (int e = tid; e < 4096; e += 256) {
      int kk = e >> 6, nn = e & 63;
      lds[kk * 65 + nn] = (n0 + nn < N) ? src[(size_t)(k0 + kk) * ldsrc + c0 + n0 + nn] : 0.f;
    }
    __syncthreads();
    for (int e = tid; e < 512; e += 256) {
      const int nn = e >> 3, kk = (e & 7) * 8;
      uint4 o;
      o.x = (unsigned)f2bf(lds[kk * 65 + nn]) | ((unsigned)f2bf(lds[(kk + 1) * 65 + nn]) << 16);
      o.y = (unsigned)f2bf(lds[(kk + 2) * 65 + nn]) | ((unsigned)f2bf(lds[(kk + 3) * 65 + nn]) << 16);
      o.z = (unsigned)f2bf(lds[(kk + 4) * 65 + nn]) | ((unsigned)f2bf(lds[(kk + 5) * 65 + nn]) << 16);
      o.w = (unsigned)f2bf(lds[(kk + 6) * 65 + nn]) | ((unsigned)f2bf(lds[(kk + 7) * 65 + nn]) << 16);
      *(uint4*)(dst + (size_t)(n0 + nn) * K + k0 + kk) = o;
    }
  }
  item0 += nitems;
}

typedef __attribute__((ext_vector_type(8))) short bf16x8;
typedef __attribute__((ext_vector_type(16))) float f32x16;
typedef __attribute__((ext_vector_type(4))) unsigned u32x4;

DEV int swz(int row, int c) { return row * 128 + ((c ^ ((row >> 1) & 7)) << 4); }

template <bool ZERO = true>
DEV void mfma_gemm_mainloop(const bf16_t* A, int lda, const bf16_t* Bt, int ldb, int K, int m0, int n0, unsigned char* lds, f32x16 (&acc)[2][2], int wv) {
  const int tid = opaque_tid(wv), lane = tid & 63, wm = wv >> 1, wn = wv & 1;
  const int l31 = lane & 31, lh = lane >> 5;
  if (ZERO) {
#pragma unroll
    for (int i = 0; i < 2; ++i)
#pragma unroll
      for (int j = 0; j < 2; ++j)
#pragma unroll
        for (int r = 0; r < 16; ++r) acc[i][j][r] = 0.f;
  }
  const int KT = K / 64;
  typedef __attribute__((address_space(3))) void* ldsp_t;
  const int prow = lane >> 3, pcp = lane & 7;
  unsigned goffA[4], goffB[4];
#pragma unroll
  for (int j = 0; j < 4; ++j) {
    const int row = 8 * (4 * wv + j) + prow, c = pcp ^ ((row >> 1) & 7);
    goffA[j] = (unsigned)(row * lda + c * 8); goffB[j] = (unsigned)(row * ldb + c * 8);
  }
  const bf16_t* Ab = A + (size_t)m0 * lda; const bf16_t* Bb = Bt + (size_t)n0 * ldb;
#define GEMM_GLDS(buf_, kt_) do { _Pragma("unroll") for (int j = 0; j < 4; ++j) { \
      __builtin_amdgcn_global_load_lds((const void*)(Ab + (kt_) * 64 + goffA[j]), (ldsp_t)(lds + (buf_) * 32768 + (4 * wv + j) * 1024), 16, 0, 0); \
      __builtin_amdgcn_global_load_lds((const void*)(Bb + (kt_) * 64 + goffB[j]), (ldsp_t)(lds + (buf_) * 32768 + 16384 + (4 * wv + j) * 1024), 16, 0, 0); } } while (0)
  __syncthreads();
  GEMM_GLDS(0, 0);
  __builtin_amdgcn_sched_barrier(0);
  asm volatile("s_waitcnt vmcnt(0)" ::: "memory");
  __syncthreads();
  __builtin_amdgcn_sched_barrier(0);
  for (int kt = 0; kt < KT; ++kt) {
    if (kt + 1 < KT) GEMM_GLDS((kt + 1) & 1, kt + 1);
    const unsigned char* as = lds + (kt & 1) * 32768; const unsigned char* bs = as + 16384;
#pragma unroll
    for (int s = 0; s < 4; ++s) {
      bf16x8 af[2], bfr[2];
#pragma unroll
      for (int i = 0; i < 2; ++i) {
        af[i] = *(const bf16x8*)(as + swz(wm * 64 + i * 32 + l31, 2 * s + lh));
        bfr[i] = *(const bf16x8*)(bs + swz(wn * 64 + i * 32 + l31, 2 * s + lh));
      }
#pragma unroll
      for (int i = 0; i < 2; ++i)
#pragma unroll
        for (int j = 0; j < 2; ++j) acc[i][j] = __builtin_amdgcn_mfma_f32_32x32x16_bf16(af[i], bfr[j], acc[i][j], 0, 0, 0);
    }
    __builtin_amdgcn_sched_barrier(0);
    asm volatile("s_waitcnt vmcnt(0)" ::: "memory");
    __syncthreads();
    __builtin_amdgcn_sched_barrier(0);
  }
}

template <class Epi>
DEV void mfma_gemm_tile(const bf16_t* A, int lda, const bf16_t* Bt, int ldb, int K, int m0, int n0, unsigned char* lds, Epi& epi, int wv) {
  const int tid = opaque_tid(wv), lane = tid & 63, wm = wv >> 1, wn = wv & 1;
  const int l31 = lane & 31, lh = lane >> 5;
  f32x16 acc[2][2];
  mfma_gemm_mainloop(A, lda, Bt, ldb, K, m0, n0, lds, acc, wv);
#pragma unroll
  for (int i = 0; i < 2; ++i)
#pragma unroll
    for (int j = 0; j < 2; ++j) {
      const int rb = m0 + wm * 64 + i * 32, cb = n0 + wn * 64 + j * 32;
      if (epi.block(rb, cb, l31, lh, acc[i][j])) continue;
#pragma unroll
      for (int r = 0; r < 16; ++r) {
        epi(rb + (r & 3) + 8 * (r >> 2) + 4 * lh, cb + l31, acc[i][j][r]);
        if ((r & 3) == 3) __builtin_amdgcn_sched_barrier(0);
      }
    }
}

typedef __attribute__((ext_vector_type(4))) float f32x4;
#define G16_DSR(dst_, base_, off_) asm volatile("ds_read_b128 %0, %1 offset:%2" : "=v"(dst_) : "v"(base_), "n"(off_) : "memory")
#define G16_WAIT5(n_, a_, b0_, b1_, b2_, b3_) asm volatile("s_waitcnt lgkmcnt(" #n_ ")" : "+v"(a_), "+v"(b0_), "+v"(b1_), "+v"(b2_), "+v"(b3_))
#define G16_WAIT1(n_, a_) asm volatile("s_waitcnt lgkmcnt(" #n_ ")" : "+v"(a_))
template <bool ZERO = true, int PB = 0>
DEV void mfma_gemm_mainloop16(const bf16_t* A, int lda, const bf16_t* Bt, int ldb, int K, int m0, int n0, unsigned char* lds, f32x4 (&acc)[4][4], int wv) {
  const int tid = opaque_tid(wv), lane = tid & 63, wm = wv >> 1, wn = wv & 1;
  const int l15 = lane & 15, lq = lane >> 4;
  if (ZERO) {
#pragma unroll
    for (int i = 0; i < 4; ++i)
#pragma unroll
      for (int j = 0; j < 4; ++j) acc[i][j] = f32x4{0.f, 0.f, 0.f, 0.f};
  }
  const int KT = K / 64;
  typedef __attribute__((address_space(3))) void* ldsp_t;
  const int prow = lane >> 3, pcp = lane & 7;
  unsigned goffA[4], goffB[4];
#pragma unroll
  for (int j = 0; j < 4; ++j) {
    const int row = 8 * (4 * wv + j) + prow, c = pcp ^ ((row >> 1) & 7);
    goffA[j] = (unsigned)(row * lda + c * 8); goffB[j] = (unsigned)(row * ldb + c * 8);
  }
  const bf16_t* Ab = A + (size_t)m0 * lda; const bf16_t* Bb = Bt + (size_t)n0 * ldb;
  const unsigned ldsb = (unsigned)(size_t)(__attribute__((address_space(3))) unsigned char*)lds;
  const unsigned fa0 = ldsb + swz(wm * 64 + l15, lq), fa1 = ldsb + swz(wm * 64 + l15, 4 + lq);
  const unsigned fb0 = ldsb + 16384 + swz(wn * 64 + l15, lq), fb1 = ldsb + 16384 + swz(wn * 64 + l15, 4 + lq);
  __syncthreads();
  GEMM_GLDS(0, 0);
  __builtin_amdgcn_sched_barrier(0);
  asm volatile("s_waitcnt vmcnt(0)" ::: "memory");
  __syncthreads();
  __builtin_amdgcn_sched_barrier(0);
  for (int kt = 0; kt < KT; ++kt) {
    if (kt + 1 < KT) {
      if (PB == 0 || PB == 4) GEMM_GLDS((kt + 1) & 1, kt + 1);
    }
    const unsigned bo = (unsigned)(kt & 1) * 32768u;
    const unsigned a0 = fa0 + bo, a1 = fa1 + bo, b0 = fb0 + bo, b1 = fb1 + bo;
    bf16x8 x0, x1, x2, x3, y0, y1, y2, y3, u0, u1, u2, u3, w0, w1, w2, w3;
    G16_DSR(x0, a0, 0); G16_DSR(y0, b0, 0); G16_DSR(y1, b0, 2048); G16_DSR(y2, b0, 4096); G16_DSR(y3, b0, 6144);
    G16_DSR(x1, a0, 2048); G16_DSR(x2, a0, 4096); G16_DSR(x3, a0, 6144);
    G16_DSR(w0, b1, 0); G16_DSR(w1, b1, 2048); G16_DSR(w2, b1, 4096); G16_DSR(w3, b1, 6144);
    G16_DSR(u0, a1, 0); G16_DSR(u1, a1, 2048); G16_DSR(u2, a1, 4096);
#define G16_ROW(i_, a_, b0_, b1_, b2_, b3_) do { \
    acc[i_][0] = __builtin_amdgcn_mfma_f32_16x16x32_bf16(a_, b0_, acc[i_][0], 0, 0, 0); acc[i_][1] = __builtin_amdgcn_mfma_f32_16x16x32_bf16(a_, b1_, acc[i_][1], 0, 0, 0); \
    acc[i_][2] = __builtin_amdgcn_mfma_f32_16x16x32_bf16(a_, b2_, acc[i_][2], 0, 0, 0); acc[i_][3] = __builtin_amdgcn_mfma_f32_16x16x32_bf16(a_, b3_, acc[i_][3], 0, 0, 0); } while (0)
#define G16_SB __builtin_amdgcn_sched_barrier(0)
    G16_SB; G16_WAIT5(10, x0, y0, y1, y2, y3);
    G16_ROW(0, x0, y0, y1, y2, y3); G16_SB;
    G16_DSR(u3, a1, 6144);
    G16_WAIT1(10, x1); G16_ROW(1, x1, y0, y1, y2, y3); G16_SB;
    G16_WAIT1(9, x2);  G16_ROW(2, x2, y0, y1, y2, y3); G16_SB;
    G16_WAIT1(8, x3);  G16_ROW(3, x3, y0, y1, y2, y3); G16_SB;
    G16_WAIT5(3, u0, w0, w1, w2, w3);
    G16_ROW(0, u0, w0, w1, w2, w3); G16_SB;
    G16_WAIT1(2, u1); G16_ROW(1, u1, w0, w1, w2, w3); G16_SB;
    G16_WAIT1(1, u2); G16_ROW(2, u2, w0, w1, w2, w3); G16_SB;
    G16_WAIT1(0, u3); G16_ROW(3, u3, w0, w1, w2, w3);
    __builtin_amdgcn_sched_barrier(0);
    asm volatile("s_waitcnt vmcnt(0)" ::: "memory");
    __syncthreads();
    __builtin_amdgcn_sched_barrier(0);
  }
}

template <int PB = 0, class Epi>
DEV void mfma_gemm_tile16(const bf16_t* A, int lda, const bf16_t* Bt, int ldb, int K, int m0, int n0, unsigned char* lds, Epi& epi, int wv) {
  const int tid = opaque_tid(wv), lane = tid & 63, wm = wv >> 1, wn = wv & 1;
  const int l15 = lane & 15, lq = lane >> 4;
  f32x4 acc[4][4];
  mfma_gemm_mainloop16<true, PB>(A, lda, Bt, ldb, K, m0, n0, lds, acc, wv);
#pragma unroll
  for (int i = 0; i < 4; ++i)
#pragma unroll
    for (int j = 0; j < 4; ++j) {
      const int rb = m0 + wm * 64 + i * 16, cb = n0 + wn * 64 + j * 16;
      if (PB >= 4) { if (acc[i][j][0] == 123.456f) epi(rb, cb, acc[i][j][1]); continue; }
      if (epi.block16(rb, cb, l15, lq, acc[i][j])) continue;
#pragma unroll
      for (int r = 0; r < 4; ++r) epi(rb + 4 * lq + r, cb + l15, acc[i][j][r]);
      __builtin_amdgcn_sched_barrier(0);
    }
}

template <int PB = 0, class Epi>
DEV void mfma_gemm16(const bf16_t* A, int lda, const bf16_t* Bt, int ldb, int K, int M, int N, unsigned char* lds, Epi epi, int wv, int cpg) {
  const int nt = N / 128, mt = M / 128;
  const int grp = blockIdx.x & 7, slot = blockIdx.x >> 3, nslots = gridDim.x >> 3, mg = mt >> 3;
  for (int l = slot; l < mg * nt; l += nslots) {
    const int g = l / (mg * cpg), r = l - g * (mg * cpg);
    mfma_gemm_tile16<PB>(A, lda, Bt, ldb, K, (grp * mg + r / cpg) * 128, (g * cpg + r % cpg) * 128, lds, epi, wv);
  }
}

template <class F> struct ElemEpi { F f; DEV bool block(int, int, int, int, const f32x16&) const { return false; } DEV bool block16(int, int, int, int, const f32x4&) const { return false; } DEV void operator()(int t, int n, float v) const { f(t, n, v); } };
template <class F> DEV ElemEpi<F> elem_epi(F f) { return ElemEpi<F>{f}; }

template <class Epi>
DEV void mfma_gemm(const bf16_t* A, int lda, const bf16_t* Bt, int ldb, int K, int M, int N, unsigned char* lds, Epi epi, int wv) {
  const int nt = N / 128, mt = M / 128;
  if ((gridDim.x & 7) == 0 && (mt & 7) == 0) {
    const int grp = blockIdx.x & 7, slot = blockIdx.x >> 3, nslots = gridDim.x >> 3, mg = mt >> 3;
    for (int l = slot; l < mg * nt; l += nslots)
      mfma_gemm_tile(A, lda, Bt, ldb, K, (grp * mg + l % mg) * 128, (l / mg) * 128, lds, epi, wv);
  } else {
    const int nitems = mt * nt;
    for (int item = blockIdx.x; item < nitems; item += gridDim.x)
      mfma_gemm_tile(A, lda, Bt, ldb, K, (item / nt) * 128, (item % nt) * 128, lds, epi, wv);
  }
}

struct ZEpi {
  bf16_t *q, *kvc, *kslc, *kwin, *vslct, *vwint, *rw; float* gate;
  DEV static void rows(bf16_t* base, int ld, int lh, const f32x16& a, float scale) {
#pragma unroll
    for (int r = 0; r < 16; ++r) base[(unsigned)(((r & 3) + 8 * (r >> 2) + 4 * lh) * ld)] = f2bf(a[r] * scale);
  }
  DEV bool block(int rb, int cb, int l31, int lh, const f32x16& a) const {
    if (cb < 512) { rows(q + (unsigned)(rb * 512 + cb + l31), 512, lh, a, 0.125f * 1.4426950408889634f); return true; }
    if (cb < 768) { rows(kvc + (unsigned)(rb * 256 + cb - 512 + l31), 256, lh, a, 1.f); return true; }
    if (cb < 896) { rows(kslc + (unsigned)(rb * 128 + cb - 768 + l31), 128, lh, a, 1.f); return true; }
    if (cb >= 1024 && cb < 1152) { rows(kwin + (unsigned)(rb * 128 + cb - 1024 + l31), 128, lh, a, 1.f); return true; }
    if (cb >= 1312 && cb < 3072) { rows(rw + (unsigned)(rb * RWC + cb - 1304 + l31), RWC, lh, a, 1.f); return true; }
    if (cb >= 3104) return true;
    if (cb == 1280 || cb == 3072) return false;
    bf16_t* dst = (cb < 1024) ? vslct : vwint;
    const int c = cb - ((cb < 1024) ? 896 : 1152) + l31;
    bf16_t* base = dst + (unsigned)((((rb >> 11) * 2 + (c >> 6)) * 64 + (c & 63)) * S_ + (rb & 2047) + 4 * lh);
#pragma unroll
    for (int g4 = 0; g4 < 4; ++g4) {
      ushort4 o; o.x = f2bf(a[4 * g4]); o.y = f2bf(a[4 * g4 + 1]); o.z = f2bf(a[4 * g4 + 2]); o.w = f2bf(a[4 * g4 + 3]);
      *(ushort4*)(base + 8 * g4) = o;
    }
    return true;
  }
  DEV static void rows16(bf16_t* base, int ld, const f32x4& a, float scale) {
#pragma unroll
    for (int r = 0; r < 4; ++r) base[(unsigned)(r * ld)] = f2bf(a[r] * scale);
  }
  DEV bool block16(int rb, int cb, int l15, int lq, const f32x4& a) const {
    const int r0 = rb + 4 * lq;
    if (cb < 512) { rows16(q + (unsigned)(r0 * 512 + cb + l15), 512, a, 0.125f * 1.4426950408889634f); return true; }
    if (cb < 768) { rows16(kvc + (unsigned)(r0 * 256 + cb - 512 + l15), 256, a, 1.f); return true; }
    if (cb < 896) { rows16(kslc + (unsigned)(r0 * 128 + cb - 768 + l15), 128, a, 1.f); return true; }
    if (cb >= 1024 && cb < 1152) { rows16(kwin + (unsigned)(r0 * 128 + cb - 1024 + l15), 128, a, 1.f); return true; }
    if (cb >= 1312 && cb < 3072) { rows16(rw + (unsigned)(r0 * RWC + cb - 1304 + l15), RWC, a, 1.f); return true; }
    if (cb >= 3104) return true;
    if (cb >= 1280 && cb < 1312) return false;
    if (cb >= 3072) return false;
    bf16_t* dst = (cb < 1024) ? vslct : vwint;
    const int c = cb - ((cb < 1024) ? 896 : 1152) + l15;
    ushort4 o; o.x = f2bf(a[0]); o.y = f2bf(a[1]); o.z = f2bf(a[2]); o.w = f2bf(a[3]);
    *(ushort4*)(dst + (unsigned)((((rb >> 11) * 2 + (c >> 6)) * 64 + (c & 63)) * S_ + (r0 & 2047))) = o;
    return true;
  }
  DEV void operator()(int t, int n, float v) const {
    if (n < 512) q[(unsigned)(t * 512 + n)] = f2bf(v * (0.125f * 1.4426950408889634f));
    else if (n < 768) kvc[(unsigned)(t * 256 + (n - 512))] = f2bf(v);
    else if (n < 896) kslc[(unsigned)(t * 128 + (n - 768))] = f2bf(v);
    else if (n < 1024) { int c = n - 896; vslct[(unsigned)((((t >> 11) * 2 + (c >> 6)) * 64 + (c & 63)) * S_ + (t & 2047))] = f2bf(v); }
    else if (n < 1152) kwin[(unsigned)(t * 128 + (n - 1024))] = f2bf(v);
    else if (n < 1280) { int c = n - 1152; vwint[(unsigned)((((t >> 11) * 2 + (c >> 6)) * 64 + (c & 63)) * S_ + (t & 2047))] = f2bf(v); }
    else if (n < 1304) gate[(unsigned)(t * 24 + (n - 1280))] = sigm(v);
    else if (n < NZ) rw[(unsigned)(t * RWC + (n - 1304))] = f2bf(v);
  }
};

DEV void ph_ztail(const Params& p, const ZEpi& e, int wv) {
  if (wv != 0) return;
  const int lane = opaque_tid(wv) & 63, l31 = lane & 31, lh = lane >> 5;
  const bf16_t* HB = (const bf16_t*)(p.ws + OFF_HB); const bf16_t* WT = (const bf16_t*)(p.ws + W_IN) + (size_t)3072 * 1024;
  for (int rb = blockIdx.x; rb < T_ / 32; rb += gridDim.x) {
    const bf16_t* ap = HB + (size_t)(32 * rb + l31) * 1024 + 8 * lh; const bf16_t* bp = WT + (size_t)l31 * 1024 + 8 * lh;
    f32x16 acc;
#pragma unroll
    for (int r = 0; r < 16; ++r) acc[r] = 0.f;
#pragma unroll 8
    for (int ks = 0; ks < 64; ++ks) acc = __builtin_amdgcn_mfma_f32_32x32x16_bf16(*(const bf16x8*)(ap + 16 * ks), *(const bf16x8*)(bp + 16 * ks), acc, 0, 0, 0);
#pragma unroll
    for (int r = 0; r < 16; ++r) e(32 * rb + (r & 3) + 8 * (r >> 2) + 4 * lh, 3072 + l31, acc[r]);
  }
}

DEV void shift8(const uint4& cur, const uint4& prv, const float* mu, float (&o)[8]) {
  float c[8], q[8]; unpack8(cur, c); unpack8(prv, q);
#pragma unroll
  for (int j = 0; j < 8; ++j) o[j] = c[j] + mu[j] * (q[j] - c[j]);
}
DEV uint4 pack8f(const float (&f)[8]) {
  uint4 u;
  u.x = (unsigned)f2bf(f[0]) | ((unsigned)f2bf(f[1]) << 16); u.y = (unsigned)f2bf(f[2]) | ((unsigned)f2bf(f[3]) << 16);
  u.z = (unsigned)f2bf(f[4]) | ((unsigned)f2bf(f[5]) << 16); u.w = (unsigned)f2bf(f[6]) | ((unsigned)f2bf(f[7]) << 16);
  return u;
}
DEV float fast_tanh(float x) { const float e = __expf(2.f * x); return 1.f - 2.f / (e + 1.f); }

DEV void ph_prep2(const Params& p, unsigned char* lds, int wv) {
  const int tid = opaque_tid(wv), lane = tid & 63, w = tid >> 6, l31 = lane & 31, lh = lane >> 5;
  const bf16_t* RW = (const bf16_t*)p.out;
  bf16_t* R = (bf16_t*)(p.ws + OFF_R); bf16_t* OMD = (bf16_t*)(p.ws + OFF_OMD); bf16_t* KP = (bf16_t*)(p.ws + OFF_KP);
  bf16_t* V = (bf16_t*)(p.ws + OFF_V); bf16_t* KB = (bf16_t*)(p.ws + OFF_KB); bf16_t* G = (bf16_t*)(p.ws + OFF_G);
  const bf16_t* W2T = (const bf16_t*)(p.ws + W_LW); const bf16_t* A2T = (const bf16_t*)(p.ws + W_LA); const bf16_t* G2T = (const bf16_t*)(p.ws + W_LG);
  const float* mu = p.in[I_MU];
  float* inv = (float*)(lds + 16384);
  unsigned char* ksm = lds + 20480;
  const uint4 zero4 = make_uint4(0u, 0u, 0u, 0u);
  for (int item = blockIdx.x; item < T_ / 32; item += gridDim.x) {
    const int t0 = item * 32; const bool first = (t0 & 2047) == 0;
    __syncthreads();
    for (int idx = tid; idx < 1024; idx += 256) {
      const int row = idx >> 5, ch = idx & 31;
      const bf16_t* src = RW + (size_t)(t0 + row) * RWC + 1536 + ch * 8;
      const uint4 cur = *(const uint4*)src;
      const uint4 prv = (first && row == 0) ? zero4 : *(const uint4*)(src - RWC);
      float x[8]; shift8(cur, prv, mu + 1536 + ch * 8, x);
      if (ch < 8) {
#pragma unroll
        for (int j = 0; j < 8; ++j) x[j] = fast_tanh(x[j]);
      } else if (ch >= 16) {
#pragma unroll
        for (int j = 0; j < 8; ++j) x[j] = sigm(x[j]);
      }
      *(uint4*)(lds + row * 512 + ((ch ^ (row & 15)) << 4)) = pack8f(x);
    }
#pragma unroll 2
    for (int row = w; row < 32; row += 4) {
      const size_t t = t0 + row;
      const bool nopv = first && row == 0;
      const bf16_t* src = RW + t * RWC + lane * 8;
      const uint4 c0 = *(const uint4*)src, c1 = *(const uint4*)(src + 512), c2 = *(const uint4*)(src + 1024);
      const uint4 p0 = nopv ? zero4 : *(const uint4*)(src - RWC), p1 = nopv ? zero4 : *(const uint4*)(src + 512 - RWC), p2 = nopv ? zero4 : *(const uint4*)(src + 1024 - RWC);
      float x[8];
      shift8(c0, p0, mu + lane * 8, x);
      *(uint4*)(R + t * 512 + lane * 8) = pack8f(x);
      shift8(c2, p2, mu + 1024 + lane * 8, x);
      *(uint4*)(V + t * 512 + lane * 8) = pack8f(x);
      shift8(c1, p1, mu + 512 + lane * 8, x);
      const uint4 kq = pack8f(x);
      *(uint4*)(ksm + row * 1024 + lane * 16) = kq;
      float kr[8]; unpack8(kq, kr);
      float ss = 0.f;
#pragma unroll
      for (int j = 0; j < 8; ++j) { const float q = kr[j] * p.in[I_KK][lane * 8 + j]; ss += q * q; }
      ss = sum8lanes(ss);
      if ((lane & 7) == 0) inv[row * 8 + (lane >> 3)] = 1.f / fmaxf(sqrtf(ss), 1e-12f);
    }
    asm volatile("s_waitcnt vmcnt(0)" ::: "memory");
    __syncthreads();
    {
      constexpr int mb = 0;
      const int arow = l31;
#pragma unroll 1
      for (int nb = 0; nb < 4; ++nb) {
        const int n = 128 * w + 32 * nb + l31;
        {
          f32x16 acc;
#pragma unroll
          for (int r = 0; r < 16; ++r) acc[r] = 0.f;
#pragma unroll
          for (int s = 0; s < 4; ++s) {
            const bf16x8 af = *(const bf16x8*)(lds + arow * 512 + (((2 * s + lh) ^ (arow & 15)) << 4));
            const bf16x8 bfr = *(const bf16x8*)(W2T + (size_t)n * 64 + 16 * s + 8 * lh);
            acc = __builtin_amdgcn_mfma_f32_32x32x16_bf16(af, bfr, acc, 0, 0, 0);
          }
          const float w0 = p.in[I_W0][n];
#pragma unroll
          for (int r = 0; r < 16; ++r) {
            const size_t t = t0 + 32 * mb + (r & 3) + 8 * (r >> 2) + 4 * lh;
            const float nx = -(w0 + acc[r]);
            const float sp = fmaxf(nx, 0.f) + __logf(1.f + __expf(-fabsf(nx)));
            const float e = __expf(-sp - 0.5f);
            OMD[t * 512 + n] = f2bf(1.f - __expf(-e));
          }
        }
        {
          f32x16 acc;
#pragma unroll
          for (int r = 0; r < 16; ++r) acc[r] = 0.f;
#pragma unroll
          for (int s = 0; s < 4; ++s) {
            const bf16x8 af = *(const bf16x8*)(lds + arow * 512 + (((8 + 2 * s + lh) ^ (arow & 15)) << 4));
            const bf16x8 bfr = *(const bf16x8*)(A2T + (size_t)n * 64 + 16 * s + 8 * lh);
            acc = __builtin_amdgcn_mfma_f32_32x32x16_bf16(af, bfr, acc, 0, 0, 0);
          }
          const int h = n >> 6, c = n & 63;
          const float a0 = p.in[I_A0][n], kkw = p.in[I_KK][n], kaw = p.in[I_KA][n];
#pragma unroll
          for (int r = 0; r < 16; ++r) {
            const int lrow = 32 * mb + (r & 3) + 8 * (r >> 2) + 4 * lh;
            const size_t t = t0 + lrow;
            const float a = sigm(a0 + acc[r]);
            const float k = bf2f(*(const bf16_t*)(ksm + lrow * 1024 + n * 2));
            const float kk = k * kkw * inv[lrow * 8 + h];
            KP[t * 512 + n] = f2bf(k * (1.f + (a - 1.f) * kaw));
            KB[(t * 8 + h) * 128 + c] = f2bf(kk);
            KB[(t * 8 + h) * 128 + 64 + c] = f2bf(kk * a);
          }
        }
        {
          f32x16 acc;
#pragma unroll
          for (int r = 0; r < 16; ++r) acc[r] = 0.f;
#pragma unroll
          for (int s = 0; s < 8; ++s) {
            const bf16x8 af = *(const bf16x8*)(lds + arow * 512 + (((16 + 2 * s + lh) ^ (arow & 15)) << 4));
            const bf16x8 bfr = *(const bf16x8*)(G2T + (size_t)n * 128 + 16 * s + 8 * lh);
            acc = __builtin_amdgcn_mfma_f32_32x32x16_bf16(af, bfr, acc, 0, 0, 0);
          }
#pragma unroll
          for (int r = 0; r < 16; ++r) {
            const size_t t = t0 + 32 * mb + (r & 3) + 8 * (r >> 2) + 4 * lh;
            G[t * 512 + n] = f2bf(acc[r]);
          }
        }
      }
    }
  }
}

DEV int swz32(int row, int c) { return row * 64 + ((c ^ ((row >> 2) & 3)) << 4); }
DEV void ph_cmp2(const Params& p, unsigned char* lds, int wv) {
  const int tid = opaque_tid(wv), lane = tid & 63, l31 = lane & 31, lh = lane >> 5;
  const bf16_t* kvc = (const bf16_t*)(p.ws + OFF_KVC);
  bf16_t* KC = (bf16_t*)(p.ws + OFF_KC); bf16_t* VCT = (bf16_t*)(p.ws + OFF_VCT);
  const float* C1 = (const float*)(p.ws + W_C1);
  for (int item = blockIdx.x; item < 128; item += gridDim.x) {
    const int kv = item >> 6, m0 = (item & 63) * 32;
    const bf16_t* W1T = (const bf16_t*)(p.ws + W_C1T) + (size_t)kv * 256 * 2048;
    const bf16_t* W2T = (const bf16_t*)(p.ws + W_C2T) + (size_t)kv * 64 * 256;
    const int am = m0 + l31, abg = am >> 7, ac = am & 127;
    const bf16_t* ap = kvc + ((size_t)(abg >> 1) * S_ + 16 * ac) * 256 + kv * 128 + (abg & 1) * 64 + 8 * lh;
    const bf16_t* bp0 = W1T + (size_t)(lh * 256 + 64 * wv + l31) * 8;
    const bf16_t* bp1 = bp0 + 32 * 8;
    f32x16 acc[2];
#pragma unroll
    for (int r = 0; r < 16; ++r) { acc[0][r] = 0.f; acc[1][r] = 0.f; }
#pragma unroll 8
    for (int ks = 0; ks < 128; ++ks) {
      const bf16x8 af = *(const bf16x8*)(ap + (ks >> 2) * 256 + (ks & 3) * 16);
      const bf16x8 b0 = *(const bf16x8*)(bp0 + (size_t)ks * (2 * 256 * 8));
      const bf16x8 b1 = *(const bf16x8*)(bp1 + (size_t)ks * (2 * 256 * 8));
      acc[0] = __builtin_amdgcn_mfma_f32_32x32x16_bf16(af, b0, acc[0], 0, 0, 0);
      acc[1] = __builtin_amdgcn_mfma_f32_32x32x16_bf16(af, b1, acc[1], 0, 0, 0);
    }
    __syncthreads();
#pragma unroll
    for (int nb = 0; nb < 2; ++nb) {
      const int n = 64 * wv + 32 * nb + l31;
      const float c1 = C1[kv * 256 + n];
#pragma unroll
      for (int r = 0; r < 16; ++r) {
        const int row = (r & 3) + 8 * (r >> 2) + 4 * lh;
        *(bf16_t*)(lds + row * 512 + (((n >> 3) ^ (row & 15)) << 4) + (n & 7) * 2) = f2bf(gelu_tanh(acc[nb][r] + c1));
      }
    }
    __syncthreads();
    if (wv < 2) {
      f32x16 o;
#pragma unroll
      for (int r = 0; r < 16; ++r) o[r] = 0.f;
#pragma unroll
      for (int s = 0; s < 16; ++s) {
        const bf16x8 af = *(const bf16x8*)(lds + l31 * 512 + (((2 * s + lh) ^ (l31 & 15)) << 4));
        const bf16x8 bfr = *(const bf16x8*)(W2T + (size_t)(32 * wv + l31) * 256 + 16 * s + 8 * lh);
        o = __builtin_amdgcn_mfma_f32_32x32x16_bf16(af, bfr, o, 0, 0, 0);
      }
      const int n = 32 * wv + l31;
      const float b2 = p.in[I_CB2][kv * 64 + n];
      if (kv == 0) {
#pragma unroll
        for (int r = 0; r < 16; ++r) { const int m = m0 + (r & 3) + 8 * (r >> 2) + 4 * lh; KC[(size_t)m * 64 + n] = f2bf(o[r] + b2); }
      } else {
#pragma unroll
        for (int g4 = 0; g4 < 4; ++g4) {
          const int m = m0 + 8 * g4 + 4 * lh, bg = m >> 7, c = m & 127;
          ushort4 q; q.x = f2bf(o[4 * g4] + b2); q.y = f2bf(o[4 * g4 + 1] + b2); q.z = f2bf(o[4 * g4 + 2] + b2); q.w = f2bf(o[4 * g4 + 3] + b2);
          *(ushort4*)(VCT + ((size_t)bg * 64 + n) * 128 + c) = q;
        }
      }
    }
  }
}

DEV float dpp_row_sum16(float x) {
  x += __int_as_float(__builtin_amdgcn_update_dpp(0, __float_as_int(x), 0xB1, 0xF, 0xF, true));
  x += __int_as_float(__builtin_amdgcn_update_dpp(0, __float_as_int(x), 0x4E, 0xF, 0xF, true));
  x += __int_as_float(__builtin_amdgcn_update_dpp(0, __float_as_int(x), 0x124, 0xF, 0xF, true));
  x += __int_as_float(__builtin_amdgcn_update_dpp(0, __float_as_int(x), 0x128, 0xF, 0xF, true));
  return x;
}

DEV void ph_scan2(const Params& p, float* lds, int wv) {
  const int tid = opaque_tid(wv);
  const bf16_t* R = (const bf16_t*)(p.ws + OFF_R); const bf16_t* OMD = (const bf16_t*)(p.ws + OFF_OMD); const bf16_t* KP = (const bf16_t*)(p.ws + OFF_KP);
  const bf16_t* V = (const bf16_t*)(p.ws + OFF_V); const bf16_t* KB = (const bf16_t*)(p.ws + OFF_KB);
  bf16_t* Y = (bf16_t*)(p.ws + OFF_Y);
  constexpr int CH = 16;
  const int kpart = tid & 15, rp = tid >> 4, k0 = kpart * 4;
  const int li = tid >> 4, lc4 = (tid & 15) * 4;
  __builtin_amdgcn_s_setprio(3);
  for (int item = blockIdx.x; item < 256; item += gridDim.x) {
    const int bh = item >> 2, vq = item & 3, b = bh >> 3, h = bh & 7;
    const int row0 = vq * 16 + rp;
    float s0 = 0.f, s1 = 0.f, s2 = 0.f, s3 = 0.f;
    ushort4 g0, g1, g2, g3, g4, g5;
#define SC_GLOAD(c0_) do { const size_t t_ = (size_t)b * S_ + (c0_) + li; const size_t o_ = t_ * 512 + h * 64 + lc4; const size_t ob_ = (t_ * 8 + h) * 128 + lc4; \
      g0 = *(const ushort4*)(R + o_); g1 = *(const ushort4*)(OMD + o_); g2 = *(const ushort4*)(KP + o_); g3 = *(const ushort4*)(V + o_); \
      g4 = *(const ushort4*)(KB + ob_); g5 = *(const ushort4*)(KB + ob_ + 64); } while (0)
#define SC_LSTORE(buf_) do { float* d_ = lds + (buf_) * (CH * 384) + li * 384 + lc4; \
      *(float4*)(d_) = make_float4(bf2f(g0.x), bf2f(g0.y), bf2f(g0.z), bf2f(g0.w)); \
      *(float4*)(d_ + 64) = make_float4(1.f - bf2f(g1.x), 1.f - bf2f(g1.y), 1.f - bf2f(g1.z), 1.f - bf2f(g1.w)); \
      *(float4*)(d_ + 128) = make_float4(bf2f(g2.x), bf2f(g2.y), bf2f(g2.z), bf2f(g2.w)); \
      *(float4*)(d_ + 192) = make_float4(bf2f(g3.x), bf2f(g3.y), bf2f(g3.z), bf2f(g3.w)); \
      *(float4*)(d_ + 256) = make_float4(bf2f(g4.x), bf2f(g4.y), bf2f(g4.z), bf2f(g4.w)); \
      *(float4*)(d_ + 320) = make_float4(bf2f(g5.x), bf2f(g5.y), bf2f(g5.z), bf2f(g5.w)); } while (0)
    __syncthreads();
    SC_GLOAD(0); SC_LSTORE(0);
    __syncthreads();
    for (int c = 0; c < S_ / CH; ++c) {
      if (c + 1 < S_ / CH) SC_GLOAD((c + 1) * CH);
      const float* base = lds + (c & 1) * (CH * 384);
      float yk[CH];
      float4 o_r[3], o_d[3], o_k[3], o_q[3], o_b[3]; float o_v[3];
#define SC_LD(slot_, i_) do { const float* tk_ = base + (i_) * 384; o_r[slot_] = *(const float4*)(tk_ + k0); o_d[slot_] = *(const float4*)(tk_ + 64 + k0); \
        o_k[slot_] = *(const float4*)(tk_ + 128 + k0); o_q[slot_] = *(const float4*)(tk_ + 256 + k0); o_b[slot_] = *(const float4*)(tk_ + 320 + k0); o_v[slot_] = tk_[192 + row0]; } while (0)
      SC_LD(0, 0); SC_LD(1, 1);
#pragma unroll
      for (int i = 0; i < CH; ++i) {
        if (i + 2 < CH) SC_LD((i + 2) % 3, i + 2);
        const float4 rr = o_r[i % 3], dd = o_d[i % 3], kp = o_k[i % 3], kk = o_q[i % 3], bb = o_b[i % 3];
        const float vv = o_v[i % 3];
        float sa = (s0 * kk.x + s1 * kk.y) + (s2 * kk.z + s3 * kk.w);
        sa = -dpp_row_sum16(sa);
        s0 = s0 * dd.x + sa * bb.x + vv * kp.x; s1 = s1 * dd.y + sa * bb.y + vv * kp.y; s2 = s2 * dd.z + sa * bb.z + vv * kp.z; s3 = s3 * dd.w + sa * bb.w + vv * kp.w;
        yk[i] = s0 * rr.x + s1 * rr.y + s2 * rr.z + s3 * rr.w;
      }
#pragma unroll
      for (int i = 0; i < 8; ++i) { const bool up = kpart & 8; const float keep = up ? yk[i + 8] : yk[i]; const float send = up ? yk[i] : yk[i + 8];
        yk[i] = keep + __int_as_float(__builtin_amdgcn_update_dpp(0, __float_as_int(send), 0x128, 0xF, 0xF, true)); }
#pragma unroll
      for (int i = 0; i < 4; ++i) { const bool up = kpart & 4; const float keep = up ? yk[i + 4] : yk[i]; const float send = up ? yk[i] : yk[i + 4];
        yk[i] = keep + SWZ_XOR(send, 4); }
#pragma unroll
      for (int i = 0; i < 2; ++i) { const bool up = kpart & 2; const float keep = up ? yk[i + 2] : yk[i]; const float send = up ? yk[i] : yk[i + 2];
        yk[i] = keep + __int_as_float(__builtin_amdgcn_update_dpp(0, __float_as_int(send), 0x4E, 0xF, 0xF, true)); }
      { const bool up = kpart & 1; const float keep = up ? yk[1] : yk[0]; const float send = up ? yk[0] : yk[1];
        yk[0] = keep + __int_as_float(__builtin_amdgcn_update_dpp(0, __float_as_int(send), 0xB1, 0xF, 0xF, true)); }
      {
        const size_t t = (size_t)b * S_ + c * CH + kpart;
        Y[(t * 8 + h) * 64 + row0] = f2bf(yk[0]);
      }
      if (c + 1 < S_ / CH) SC_LSTORE((c + 1) & 1);
      __syncthreads();
    }
  }
  __builtin_amdgcn_s_setprio(0);
}

typedef __attribute__((ext_vector_type(4))) short s16x4;
constexpr float LOG2E = 1.4426950408889634f;

DEV bf16x8 pack8(const f32x16& x, int s) {
  u32x4 q;
  if (s == 0)
    asm volatile("v_cvt_pk_bf16_f32 %0, %4, %5\n\tv_cvt_pk_bf16_f32 %1, %6, %7\n\tv_cvt_pk_bf16_f32 %2, %8, %9\n\tv_cvt_pk_bf16_f32 %3, %10, %11\n\ts_nop 1"
                 : "=&v"(q[0]), "=&v"(q[1]), "=&v"(q[2]), "=&v"(q[3])
                 : "v"(x[0]), "v"(x[1]), "v"(x[2]), "v"(x[3]), "v"(x[4]), "v"(x[5]), "v"(x[6]), "v"(x[7]));
  else
    asm volatile("v_cvt_pk_bf16_f32 %0, %4, %5\n\tv_cvt_pk_bf16_f32 %1, %6, %7\n\tv_cvt_pk_bf16_f32 %2, %8, %9\n\tv_cvt_pk_bf16_f32 %3, %10, %11\n\ts_nop 1"
                 : "=&v"(q[0]), "=&v"(q[1]), "=&v"(q[2]), "=&v"(q[3])
                 : "v"(x[8]), "v"(x[9]), "v"(x[10]), "v"(x[11]), "v"(x[12]), "v"(x[13]), "v"(x[14]), "v"(x[15]));
  return __builtin_bit_cast(bf16x8, q);
}

DEV int vswz(int d, int chunk, int half) { return d * 128 + ((chunk ^ ((d >> 1) & 7)) << 4) + ((half ^ ((d >> 4) & 1)) << 3); }


DEV void ph_nsa_mfma(const Params& p, unsigned char* lds, unsigned* ctr, int wv) {
  const bf16_t* Q = (const bf16_t*)(p.ws + OFF_Q);
  const bf16_t* KC = (const bf16_t*)(p.ws + OFF_KC); const bf16_t* VCT = (const bf16_t*)(p.ws + OFF_VCT);
  const bf16_t* KSLC = (const bf16_t*)(p.ws + OFF_KSLC); const bf16_t* KWIN = (const bf16_t*)(p.ws + OFF_KWIN);
  const bf16_t* VSLCT = (const bf16_t*)(p.ws + OFF_VSLCT); const bf16_t* VWINT = (const bf16_t*)(p.ws + OFF_VWINT);
  const float* GATE = (const float*)(p.ws + OFF_GATE);
  bf16_t* YN = (bf16_t*)(p.ws + OFF_YNSA);
  unsigned char* Kl = lds;
  unsigned char* Vl = lds + 16384;
  float* tb = (float*)(lds + 32768);
  float* impP = (float*)(lds + 34816);
  float* scl = (float*)(lds + 34816 + 16896);
  unsigned* selm = (unsigned*)(lds + 34816 + 16896 + 4224);
  int* sitem = (int*)(lds + 34816 + 16896 + 4224 + 128);
  const int NITEMS = B_ * 2 * 64;
  for (;;) {
    __syncthreads();
    if (opaque_tid(wv) == 0) sitem[0] = (int)atomicAdd(ctr, 1u);
    __syncthreads();
    const int item = sitem[0];
    if (item >= NITEMS) break;
    const int tid = opaque_tid(wv);
    const int lane = tid & 63, hp = tid >> 6, l31 = lane & 31, lh = lane >> 5;
    const int qb = 63 - (item >> 4), g = item & 1, b = (item >> 1) & 7;
    const int bg = b * 2 + g, head = g * 4 + hp;
    const int s0 = qb * 32, cur = s0 >> 6;
    const int sq = s0 + l31;
    const size_t tq = (size_t)b * S_ + sq;
    for (int e = tid; e < 512; e += 256) { int hh = e >> 7, d = e & 127; tb[e] = p.in[I_RELB][T5B[d] * 8 + g * 4 + hh] * LOG2E; }
    bf16x8 qf[4];
#pragma unroll
    for (int s = 0; s < 4; ++s) qf[s] = *(const bf16x8*)(Q + tq * 512 + head * 64 + 16 * s + 8 * lh);
    const float* mytb = tb + hp * 128;
    const int nct = (qb <= 31) ? 1 : 2;
    int wlo = s0 - 511; if (wlo < 0) wlo = 0;
    const int ktlo = wlo >> 6;
    const int nslc = cur + 1, nwin = cur - ktlo + 1;
    const int NT = 2 * nct + nslc + nwin;
#define GET_TILE(ti_, kp_, vp_, ks_, vs_, md_, p0_) do { \
      const int ti__ = (ti_); \
      if (ti__ < 2 * nct) { \
        const int c0 = (ti__ < nct ? ti__ : ti__ - nct) * 64; \
        kp_ = KC + ((size_t)bg * 128 + c0) * 64; ks_ = 64; vp_ = VCT + (size_t)bg * 64 * 128 + c0; vs_ = 128; md_ = ti__ < nct ? 0 : 1; p0_ = c0; \
      } else if (ti__ < 2 * nct + nslc) { \
        const int k0 = (ti__ - 2 * nct) * 64; \
        kp_ = KSLC + ((size_t)b * S_ + k0) * 128 + g * 64; ks_ = 128; vp_ = VSLCT + (size_t)bg * 64 * S_ + k0; vs_ = S_; md_ = 2; p0_ = k0; \
      } else { \
        const int k0 = (ktlo + ti__ - 2 * nct - nslc) * 64; \
        kp_ = KWIN + ((size_t)b * S_ + k0) * 128 + g * 64; ks_ = 128; vp_ = VWINT + (size_t)bg * 64 * S_ + k0; vs_ = S_; md_ = 3; p0_ = k0; \
      } } while (0)
    uint4 rk0, rk1, rv0, rv1;
    const int srow0 = tid >> 3, srow1 = (tid + 256) >> 3, sc = tid & 7;
#define NSA_GLOAD(kp, vp, kstride, vstride) do { \
      rk0 = *(const uint4*)((kp) + (size_t)srow0 * (kstride) + sc * 8); rk1 = *(const uint4*)((kp) + (size_t)srow1 * (kstride) + sc * 8); \
      rv0 = *(const uint4*)((vp) + (size_t)srow0 * (vstride) + sc * 8); rv1 = *(const uint4*)((vp) + (size_t)srow1 * (vstride) + sc * 8); } while (0)
#define NSA_LSTORE(buf) do { \
      *(uint4*)(Kl + (buf) * 8192 + swz(srow0, sc)) = rk0; *(uint4*)(Kl + (buf) * 8192 + swz(srow1, sc)) = rk1; \
      { uint4 v = rv0; if ((srow0 >> 4) & 1) { unsigned tx = v.x, ty = v.y; v.x = v.z; v.y = v.w; v.z = tx; v.w = ty; } \
        *(uint4*)(Vl + (buf) * 8192 + srow0 * 128 + ((sc ^ ((srow0 >> 1) & 7)) << 4)) = v; } \
      { uint4 v = rv1; if ((srow1 >> 4) & 1) { unsigned tx = v.x, ty = v.y; v.x = v.z; v.y = v.w; v.z = tx; v.w = ty; } \
        *(uint4*)(Vl + (buf) * 8192 + srow1 * 128 + ((sc ^ ((srow1 >> 1) & 7)) << 4)) = v; } } while (0)
    f32x16 O[2]; unsigned OUTP[2][8];
#pragma unroll
    for (int r = 0; r < 16; ++r) { O[0][r] = 0.f; O[1][r] = 0.f; }
#pragma unroll
    for (int r = 0; r < 8; ++r) { OUTP[0][r] = 0u; OUTP[1][r] = 0u; }
    float m = NEGF, l = 0.f;
    float invl_cmp = 0.f, m_cmpe = 0.f;
    float carry_prev = 0.f;
    unsigned mymask = 0u;
    const bf16_t *kpn, *vpn; int ksn, vsn, mode, pos0, moden, pos0n;
    GET_TILE(0, kpn, vpn, ksn, vsn, mode, pos0);
    NSA_GLOAD(kpn, vpn, ksn, vsn); NSA_LSTORE(0);
    __syncthreads();
    for (int ti = 0; ti < NT; ++ti) {
      moden = mode; pos0n = pos0;
      if (ti + 1 < NT) { GET_TILE(ti + 1, kpn, vpn, ksn, vsn, moden, pos0n); NSA_GLOAD(kpn, vpn, ksn, vsn); }
      if (ti == nct) {
        const float g0 = GATE[tq * 24 + head * 3];
        const float il = l > 0.f ? 1.f / l : 0.f;
#pragma unroll
        for (int r = 0; r < 8; ++r) {
          OUTP[0][r] = (unsigned)f2bf(g0 * il * O[0][2 * r]) | ((unsigned)f2bf(g0 * il * O[0][2 * r + 1]) << 16);
          OUTP[1][r] = (unsigned)f2bf(g0 * il * O[1][2 * r]) | ((unsigned)f2bf(g0 * il * O[1][2 * r + 1]) << 16);
        }
#pragma unroll
        for (int r = 0; r < 16; ++r) { O[0][r] = 0.f; O[1][r] = 0.f; }
        invl_cmp = il; m_cmpe = (m < -1e29f) ? 0.f : m; carry_prev = 0.f;
      }
      if (ti == 2 * nct) {
        __syncthreads();
        {
          const int q = tid >> 3, jb = (tid & 7) * 4;
#pragma unroll
          for (int jj = 0; jj < 4; ++jj) {
            const int j = jb + jj;
            float imp = impP[(0 * 32 + q) * 33 + j] + impP[(1 * 32 + q) * 33 + j] + impP[(2 * 32 + q) * 33 + j] + impP[(3 * 32 + q) * 33 + j];
            const bool forced = (j == 0) || (j == cur) || (j == cur - 1);
            scl[q * 33 + j] = (j > cur) ? NEGF : imp + (forced ? 1.0e4f : 0.f);
          }
          if (tid < 32) selm[tid] = 0u;
        }
        __syncthreads();
        {
          const int q = tid >> 3, jb = (tid & 7) * 4;
          unsigned bits = 0u;
#pragma unroll
          for (int jj = 0; jj < 4; ++jj) {
            const int j = jb + jj;
            const float sj = scl[q * 33 + j]; int rank = 0;
#pragma unroll 1
            for (int i = 0; i < 32; ++i) { const float si = scl[q * 33 + i]; rank += (si > sj || (si == sj && i < j)) ? 1 : 0; }
            if (rank < 16 && j <= cur) bits |= 1u << j;
          }
          if (bits) atomicOr(&selm[q], bits);
        }
        __syncthreads();
        mymask = selm[l31];
        m = NEGF; l = 0.f;
      }
      if (ti == 2 * nct + nslc) {
        const float g1 = GATE[tq * 24 + head * 3 + 1];
        const float il = l > 0.f ? 1.f / l : 0.f;
#pragma unroll
        for (int r = 0; r < 8; ++r) {
#pragma unroll
          for (int db = 0; db < 2; ++db) {
            const float lo = __uint_as_float(OUTP[db][r] << 16) + g1 * il * O[db][2 * r], hi = __uint_as_float(OUTP[db][r] & 0xffff0000u) + g1 * il * O[db][2 * r + 1];
            OUTP[db][r] = (unsigned)f2bf(lo) | ((unsigned)f2bf(hi) << 16);
          }
        }
#pragma unroll
        for (int r = 0; r < 16; ++r) { O[0][r] = 0.f; O[1][r] = 0.f; }
        m = NEGF; l = 0.f;
      }
      const unsigned char* kb_ = Kl + (ti & 1) * 8192; const unsigned char* vb_ = Vl + (ti & 1) * 8192;
      f32x16 S[2];
#pragma unroll
      for (int r = 0; r < 16; ++r) { S[0][r] = 0.f; S[1][r] = 0.f; }
#pragma unroll
      for (int s = 0; s < 4; ++s) {
        bf16x8 k0 = *(const bf16x8*)(kb_ + swz(l31, 2 * s + lh));
        bf16x8 k1 = *(const bf16x8*)(kb_ + swz(32 + l31, 2 * s + lh));
        S[0] = __builtin_amdgcn_mfma_f32_32x32x16_bf16(k0, qf[s], S[0], 0, 0, 0);
        S[1] = __builtin_amdgcn_mfma_f32_32x32x16_bf16(k1, qf[s], S[1], 0, 0, 0);
      }
      __builtin_amdgcn_sched_barrier(0);
      const int kmul = (mode < 2) ? 16 : 1;
      const int d0 = ((mode < 2) ? (sq - 31 - 16 * pos0) : (sq - pos0)) - kmul * 4 * lh;
      const unsigned selbit = (mode == 2) ? ((mymask >> (pos0 >> 6)) & 1u) : 1u;
      const unsigned dmaxl = selbit ? ((mode == 3) ? 512u : 0x7fffffffu) : 0u;
      float mx = NEGF;
      const int dmin = ((mode < 2) ? (s0 - 31 - 16 * (pos0 + 63)) : (s0 - (pos0 + 63)));
      const int dmaxt = ((mode < 2) ? (s0 + 31 - 31 - 16 * pos0) : (s0 + 31 - pos0));
      const bool fast = (dmin >= 113) && (mode != 3 || dmaxt < 512);
      if (fast) {
        const float cb = mytb[127];
        const bool on = dmaxl != 0u;
#pragma unroll
        for (int kb = 0; kb < 2; ++kb)
#pragma unroll
          for (int r = 0; r < 16; ++r) { const float v = on ? S[kb][r] + cb : NEGF; S[kb][r] = v; mx = fmaxf(mx, v); }
      } else {
#pragma unroll
      for (int kb = 0; kb < 2; ++kb)
#pragma unroll
        for (int r = 0; r < 16; ++r) {
          const int koff = 32 * kb + (r & 3) + 8 * (r >> 2);
          const unsigned dist = (unsigned)(d0 - kmul * koff);
          const unsigned di = dist < 127u ? dist : 127u;
          float bias = mytb[di];
          asm volatile("" : "+v"(bias));
          const float v = (dist < dmaxl) ? S[kb][r] + bias : NEGF;
          S[kb][r] = v;
          mx = fmaxf(mx, v);
        }
      }
      mx = xor32_max(mx);
      if (mode == 1) {
        float lastother = carry_prev;
#pragma unroll
        for (int kb = 0; kb < 2; ++kb)
#pragma unroll
          for (int g4 = 0; g4 < 4; ++g4) {
            float pr[4];
#pragma unroll
            for (int i = 0; i < 4; ++i) pr[i] = __builtin_amdgcn_exp2f(S[kb][g4 * 4 + i] - m_cmpe) * invl_cmp;
            const float own = pr[0] + pr[1] + pr[2] + 0.5f * pr[3];
            const float cr = 0.5f * pr[3];
            const float other = __uint_as_float(xor32_get(__float_as_uint(cr), lh));
            const float tot = own + (lh ? other : lastother);
            lastother = other;
            const int j = (pos0 >> 2) + 8 * kb + 2 * g4 + lh;
            impP[(hp * 32 + l31) * 33 + j] = tot;
          }
        carry_prev = lastother;
      } else {
        const float mn = fmaxf(m, mx);
        const float alpha = __builtin_amdgcn_exp2f(m - mn);
        const float mne = (mn < -1e29f) ? 0.f : mn;
        float rs = 0.f;
#pragma unroll
        for (int kb = 0; kb < 2; ++kb)
#pragma unroll
          for (int r = 0; r < 16; ++r) { const float pr = __builtin_amdgcn_exp2f(S[kb][r] - mne); S[kb][r] = pr; rs += pr; }
        rs = xor32_sum(rs);
        l = l * alpha + rs; m = mn;
#pragma unroll
        for (int r = 0; r < 16; ++r) { O[0][r] *= alpha; O[1][r] *= alpha; }
        __builtin_amdgcn_sched_barrier(0);
#pragma unroll
        for (int kb = 0; kb < 2; ++kb)
#pragma unroll
          for (int s2 = 0; s2 < 2; ++s2) {
            const bf16x8 pk = pack8(S[kb], s2);
            const int ch = 4 * kb + 2 * s2;
#pragma unroll
            for (int db = 0; db < 2; ++db) {
              const int d = 32 * db + l31;
              s16x4 lo = *(const s16x4*)(vb_ + vswz(d, ch, lh));
              s16x4 hi = *(const s16x4*)(vb_ + vswz(d, ch + 1, lh));
              const bf16x8 vf = __builtin_shufflevector(lo, hi, 0, 1, 2, 3, 4, 5, 6, 7);
              O[db] = __builtin_amdgcn_mfma_f32_32x32x16_bf16(vf, pk, O[db], 0, 0, 0);
            }
          }
      }
      if (ti + 1 < NT) NSA_LSTORE((ti + 1) & 1);
      __syncthreads();
      mode = moden; pos0 = pos0n;
    }
    {
      const float g2 = GATE[tq * 24 + head * 3 + 2];
      const float il = l > 0.f ? 1.f / l : 0.f;
#pragma unroll
      for (int db = 0; db < 2; ++db)
#pragma unroll
        for (int g4 = 0; g4 < 4; ++g4) {
          ushort4 o;
          o.x = f2bf(__uint_as_float(OUTP[db][g4 * 2] << 16) + g2 * il * O[db][g4 * 4 + 0]);
          o.y = f2bf(__uint_as_float(OUTP[db][g4 * 2] & 0xffff0000u) + g2 * il * O[db][g4 * 4 + 1]);
          o.z = f2bf(__uint_as_float(OUTP[db][g4 * 2 + 1] << 16) + g2 * il * O[db][g4 * 4 + 2]);
          o.w = f2bf(__uint_as_float(OUTP[db][g4 * 2 + 1] & 0xffff0000u) + g2 * il * O[db][g4 * 4 + 3]);
          *(ushort4*)(YN + tq * 512 + head * 64 + 32 * db + 8 * g4 + 4 * lh) = o;
        }
    }
  }
}

typedef __attribute__((ext_vector_type(2))) float f32x2;
DEV void ph_conv_tables8(const Params& p, int wv) {
  const int tid_ = opaque_tid(wv);
  const int lane = tid_ & 63;
  const int wg = blockIdx.x * 4 + (tid_ >> 6), nw = gridDim.x * 4;
  for (int rr = wg; rr < 2 * 16384; rr += nw) {
    const int tb = rr >> 14, row = rr & 16383;
    const float* src = (tb ? p.in[I_PV] : p.in[I_PU]) + (size_t)row * 1024 + lane * 16;
    float x[16];
#pragma unroll
    for (int i = 0; i < 4; ++i) { const float4 v = ((const float4*)src)[i]; x[4 * i] = v.x; x[4 * i + 1] = v.y; x[4 * i + 2] = v.z; x[4 * i + 3] = v.w; }
    float mx = 0.f;
#pragma unroll
    for (int i = 0; i < 16; ++i) mx = fmaxf(mx, fabsf(x[i]));
    mx = wave_max(mx);
    const float sc = mx > 0.f ? 240.f / mx : 0.f;
    unsigned w[4];
#pragma unroll
    for (int i = 0; i < 4; ++i) {
      int q = __builtin_amdgcn_cvt_pk_fp8_f32(x[4 * i] * sc, x[4 * i + 1] * sc, 0, false);
      q = __builtin_amdgcn_cvt_pk_fp8_f32(x[4 * i + 2] * sc, x[4 * i + 3] * sc, q, true);
      w[i] = (unsigned)q;
    }
    unsigned char* dst = p.ws + (tb ? OFF_V8 : OFF_U8) + (size_t)row * 1024 + lane * 16;
    *(uint4*)dst = make_uint4(w[0], w[1], w[2], w[3]);
    if (lane == 0) ((float*)(p.ws + OFF_SC8))[rr] = mx * (1.f / 240.f);
  }
}

DEV float dot16f8(const uint4& r, const float (&x)[16]) {
  f32x2 a;
  float s;
  a = __builtin_amdgcn_cvt_pk_f32_fp8((int)r.x, false); s = a.x * x[0] + a.y * x[1];
  a = __builtin_amdgcn_cvt_pk_f32_fp8((int)r.x, true);  s += a.x * x[2] + a.y * x[3];
  a = __builtin_amdgcn_cvt_pk_f32_fp8((int)r.y, false); s += a.x * x[4] + a.y * x[5];
  a = __builtin_amdgcn_cvt_pk_f32_fp8((int)r.y, true);  s += a.x * x[6] + a.y * x[7];
  a = __builtin_amdgcn_cvt_pk_f32_fp8((int)r.z, false); s += a.x * x[8] + a.y * x[9];
  a = __builtin_amdgcn_cvt_pk_f32_fp8((int)r.z, true);  s += a.x * x[10] + a.y * x[11];
  a = __builtin_amdgcn_cvt_pk_f32_fp8((int)r.w, false); s += a.x * x[12] + a.y * x[13];
  a = __builtin_amdgcn_cvt_pk_f32_fp8((int)r.w, true);  s += a.x * x[14] + a.y * x[15];
  return s;
}
DEV void axpy16f8(const uint4& r, float w, float (&acc)[16]) {
  f32x2 a;
  a = __builtin_amdgcn_cvt_pk_f32_fp8((int)r.x, false); acc[0] += w * a.x; acc[1] += w * a.y;
  a = __builtin_amdgcn_cvt_pk_f32_fp8((int)r.x, true);  acc[2] += w * a.x; acc[3] += w * a.y;
  a = __builtin_amdgcn_cvt_pk_f32_fp8((int)r.y, false); acc[4] += w * a.x; acc[5] += w * a.y;
  a = __builtin_amdgcn_cvt_pk_f32_fp8((int)r.y, true);  acc[6] += w * a.x; acc[7] += w * a.y;
  a = __builtin_amdgcn_cvt_pk_f32_fp8((int)r.z, false); acc[8] += w * a.x; acc[9] += w * a.y;
  a = __builtin_amdgcn_cvt_pk_f32_fp8((int)r.z, true);  acc[10] += w * a.x; acc[11] += w * a.y;
  a = __builtin_amdgcn_cvt_pk_f32_fp8((int)r.w, false); acc[12] += w * a.x; acc[13] += w * a.y;
  a = __builtin_amdgcn_cvt_pk_f32_fp8((int)r.w, true);  acc[14] += w * a.x; acc[15] += w * a.y;
}

DEV void ph_peer_gather3(const Params& p, int dummy, int wv) {
  const int tid_ = opaque_tid(wv);
  const int lane = tid_ & 63;
  const int wg = blockIdx.x * 4 + (tid_ >> 6), nw = gridDim.x * 4;
  const int* IDX = (const int*)(p.ws + OFF_IDX); const float* GP = (const float*)(p.ws + OFF_GP);
  const unsigned char* U8 = p.ws + OFF_U8; const unsigned char* V8 = p.ws + OFF_V8;
  const float* SCU = (const float*)(p.ws + OFF_SC8); const float* SCV = SCU + 16384;
  float* HW = (float*)(p.ws + OFF_HW);
  for (int t = wg; t < T_; t += nw) {
    const float* irow = p.out + (size_t)t * D_ + lane * 16;
    float x[16];
#pragma unroll
    for (int i = 0; i < 4; ++i) { const float4 v = ((const float4*)irow)[i]; x[4 * i] = v.x; x[4 * i + 1] = v.y; x[4 * i + 2] = v.z; x[4 * i + 3] = v.w; }
    const int id0 = IDX[(size_t)t * 128 + lane], id1 = IDX[(size_t)t * 128 + 64 + lane];
    const float gu0 = GP[(size_t)t * 128 + lane], gu1 = GP[(size_t)t * 128 + 64 + lane];
    const float su0 = SCU[id0], su1 = SCU[id1], sv0 = SCV[id0], sv1 = SCV[id1];
    float hw0 = 0.f, hw1 = 0.f;
    uint4 ca[8];
#pragma unroll
    for (int k = 0; k < 8; ++k) { const int id = __builtin_amdgcn_readlane(id0, k); ca[k] = *(const uint4*)(U8 + (size_t)id * 1024 + lane * 16); }
    for (int gi = 0; gi < 16; ++gi) {
      uint4 na[8];
      if (gi < 15) {
        const int idh = (gi + 1 < 8) ? id0 : id1;
#pragma unroll
        for (int k = 0; k < 8; ++k) { const int id = __builtin_amdgcn_readlane(idh, ((gi + 1) & 7) * 8 + k); na[k] = *(const uint4*)(U8 + (size_t)id * 1024 + lane * 16); }
      }
      float pt[8];
#pragma unroll
      for (int k = 0; k < 8; ++k) pt[k] = dot16f8(ca[k], x);
#pragma unroll
      for (int i = 0; i < 4; ++i) { const bool up = lane & 4; const float keep = up ? pt[i + 4] : pt[i]; const float send = up ? pt[i] : pt[i + 4]; pt[i] = keep + SWZ_XOR(send, 4); }
#pragma unroll
      for (int i = 0; i < 2; ++i) { const bool up = lane & 2; const float keep = up ? pt[i + 2] : pt[i]; const float send = up ? pt[i] : pt[i + 2]; pt[i] = keep + SWZ_XOR(send, 2); }
      { const bool up = lane & 1; const float keep = up ? pt[1] : pt[0]; const float send = up ? pt[0] : pt[1]; pt[0] = keep + SWZ_XOR(send, 1); }
      float tot = pt[0];
      tot += SWZ_XOR(tot, 8); tot += SWZ_XOR(tot, 16); tot = xor32_sum(tot);
      if ((lane >> 3) == (gi & 7)) { if (gi < 8) hw0 = gu0 * gelu_tanh(tot * su0) * sv0; else hw1 = gu1 * gelu_tanh(tot * su1) * sv1; }
      if (gi < 15) {
#pragma unroll
        for (int k = 0; k < 8; ++k) ca[k] = na[k];
      }
    }
    HW[(size_t)t * 128 + lane] = gu0 * gelu_tanh(hw0 * su0) * sv0; HW[(size_t)t * 128 + 64 + lane] = gu1 * gelu_tanh(hw1 * su1) * sv1;
  }
  for (int t = wg; t < T_; t += nw) {
    const int id0 = IDX[(size_t)t * 128 + lane], id1 = IDX[(size_t)t * 128 + 64 + lane];
    const float hw0 = HW[(size_t)t * 128 + lane], hw1 = HW[(size_t)t * 128 + 64 + lane];
    float acc[16];
#pragma unroll
    for (int i = 0; i < 16; ++i) acc[i] = 0.f;
    {
      uint4 ca[8];
#pragma unroll
      for (int k = 0; k < 8; ++k) { const int id = __builtin_amdgcn_readlane(id0, k); ca[k] = *(const uint4*)(V8 + (size_t)id * 1024 + lane * 16); }
      for (int gi = 0; gi < 16; ++gi) {
        uint4 na[8];
        if (gi < 15) {
          const int idh = (gi + 1 < 8) ? id0 : id1;
#pragma unroll
          for (int k = 0; k < 8; ++k) { const int id = __builtin_amdgcn_readlane(idh, ((gi + 1) & 7) * 8 + k); na[k] = *(const uint4*)(V8 + (size_t)id * 1024 + lane * 16); }
        }
        const float hwh = (gi < 8) ? hw0 : hw1;
#pragma unroll
        for (int k = 0; k < 8; ++k) {
          const float w = __int_as_float(__builtin_amdgcn_readlane(__float_as_int(hwh), (gi & 7) * 8 + k));
          axpy16f8(ca[k], w, acc);
        }
        if (gi < 15) {
#pragma unroll
          for (int k = 0; k < 8; ++k) ca[k] = na[k];
        }
      }
    }
    const float* irow = p.out + (size_t)t * D_ + lane * 16;
    float x[16];
#pragma unroll
    for (int i = 0; i < 4; ++i) { const float4 v = ((const float4*)irow)[i]; x[4 * i] = v.x; x[4 * i + 1] = v.y; x[4 * i + 2] = v.z; x[4 * i + 3] = v.w; }
    float* orow = dummy ? (float*)(p.ws + OFF_KVC) + (size_t)(t & 8191) * D_ + lane * 16 : p.out + (size_t)t * D_ + lane * 16;
    float sum = 0.f;
#pragma unroll
    for (int i = 0; i < 16; ++i) { x[i] = ALPHA * x[i] + acc[i]; sum += x[i]; }
    const float mu = wave_sum(sum) * (1.f / D_);
    float vs = 0.f;
#pragma unroll
    for (int i = 0; i < 16; ++i) { x[i] -= mu; vs += x[i] * x[i]; }
    const float rs = rsqrtf(wave_sum(vs) * (1.f / D_) + 1e-5f);
    const float4* gg = (const float4*)(p.in[I_LNFG] + lane * 16); const float4* bb = (const float4*)(p.in[I_LNFB] + lane * 16);
#pragma unroll
    for (int i = 0; i < 4; ++i) {
      float4 g4 = gg[i], b4 = bb[i];
      ((float4*)orow)[i] = make_float4(x[4 * i] * rs * g4.x + b4.x, x[4 * i + 1] * rs * g4.y + b4.y, x[4 * i + 2] * rs * g4.z + b4.z, x[4 * i + 3] * rs * g4.w + b4.w);
    }
  }
}

typedef __attribute__((ext_vector_type(16))) float f32x16v;
typedef __attribute__((ext_vector_type(32))) float f32x32v;
typedef __attribute__((ext_vector_type(6))) unsigned u32x6v;
DEV float half_max(float v) { v = fmaxf(v, SWZ_XOR(v, 1)); v = fmaxf(v, SWZ_XOR(v, 2)); v = fmaxf(v, SWZ_XOR(v, 4)); v = fmaxf(v, SWZ_XOR(v, 8)); v = fmaxf(v, SWZ_XOR(v, 16)); return v; }
DEV float half_sum(float v) { v += SWZ_XOR(v, 1); v += SWZ_XOR(v, 2); v += SWZ_XOR(v, 4); v += SWZ_XOR(v, 8); v += SWZ_XOR(v, 16); return v; }
DEV void ph_conv_tables6(const Params& p, int wv) {
  const int tid_ = opaque_tid(wv);
  const int lane = tid_ & 63, l31 = lane & 31, lh = lane >> 5;
  const int wg = blockIdx.x * 4 + (tid_ >> 6), nw = gridDim.x * 4;
  for (int rp = wg; rp < 16384; rp += nw) {
    const int rr = 2 * rp + lh, tb = rr >> 14, row = rr & 16383;
    const float* src = (tb ? p.in[I_PV] : p.in[I_PU]) + (size_t)row * 1024 + l31 * 32;
    f32x16v a, b;
    float mx = 0.f;
#pragma unroll
    for (int i = 0; i < 8; ++i) { const float4 v = ((const float4*)src)[i]; a[2 * i] = v.x; b[2 * i] = v.y; a[2 * i + 1] = v.z; b[2 * i + 1] = v.w; }
#pragma unroll
    for (int i = 0; i < 16; ++i) mx = fmaxf(mx, fmaxf(fabsf(a[i]), fabsf(b[i])));
    mx = half_max(mx);
    const float sc = mx > 0.f ? 7.5f / mx : 0.f;
#pragma unroll
    for (int i = 0; i < 16; ++i) { a[i] *= sc; b[i] *= sc; }
    const u32x6v w = __builtin_amdgcn_cvt_scalef32_2xpk16_fp6_f32(a, b, 1.0f);
    unsigned char* dst = p.ws + (tb ? OFF_V6 : OFF_U6) + (size_t)row * 768 + l31 * 8;
    *(uint2*)dst = make_uint2(w[0], w[1]); *(uint2*)(dst + 256) = make_uint2(w[2], w[3]); *(uint2*)(dst + 512) = make_uint2(w[4], w[5]);
    if (l31 == 0) ((float*)(p.ws + OFF_SC8))[rr] = mx * (1.f / 7.5f);
  }
}

DEV u32x6v ld24(const unsigned char* ptr) {
  const uint2 a = *(const uint2*)ptr, b = *(const uint2*)(ptr + 256), c = *(const uint2*)(ptr + 512);
  u32x6v w; w[0] = a.x; w[1] = a.y; w[2] = b.x; w[3] = b.y; w[4] = c.x; w[5] = c.y; return w;
}
DEV void ph_peer_gather6(const Params& p, int dummy, int wv) {
  const int tid_ = opaque_tid(wv);
  const int lane = tid_ & 63, l31 = lane & 31, lh = lane >> 5;
  const int wg = blockIdx.x * 4 + wv, nw = gridDim.x * 4;
  const int* IDX = (const int*)(p.ws + OFF_IDX); const float* GP = (const float*)(p.ws + OFF_GP);
  const unsigned char* U6 = p.ws + OFF_U6; const unsigned char* V6 = p.ws + OFF_V6;
  const float* SCU = (const float*)(p.ws + OFF_SC8); const float* SCV = SCU + 16384;
  float* HW = (float*)(p.ws + OFF_HW);
  for (int t = wg; t < T_; t += nw) {
    float x[32];
    {
      const float4* irow = (const float4*)(p.out + (size_t)t * D_ + l31 * 32);
#pragma unroll
      for (int i = 0; i < 8; ++i) { const float4 v = irow[i]; x[4 * i] = v.x; x[4 * i + 1] = v.y; x[4 * i + 2] = v.z; x[4 * i + 3] = v.w; }
    }
    const int id0 = IDX[(size_t)t * 128 + lane], id1 = IDX[(size_t)t * 128 + 64 + lane];
    const float gu0 = GP[(size_t)t * 128 + lane], gu1 = GP[(size_t)t * 128 + 64 + lane];
    const float su0 = SCU[id0], su1 = SCU[id1], sv0 = SCV[id0], sv1 = SCV[id1];
    float hw0 = 0.f, hw1 = 0.f;
    u32x6v ca[4];
#pragma unroll
    for (int q = 0; q < 4; ++q) { const int ida = __builtin_amdgcn_readlane(id0, 2 * q), idb = __builtin_amdgcn_readlane(id0, 2 * q + 1); ca[q] = ld24(U6 + (size_t)(lh ? idb : ida) * 768 + l31 * 8); }
    for (int gi = 0; gi < 16; ++gi) {
      u32x6v na[4];
      if (gi < 15) {
        const int idh = (gi + 1 < 8) ? id0 : id1;
#pragma unroll
        for (int q = 0; q < 4; ++q) {
          const int ida = __builtin_amdgcn_readlane(idh, ((gi + 1) & 7) * 8 + 2 * q), idb = __builtin_amdgcn_readlane(idh, ((gi + 1) & 7) * 8 + 2 * q + 1);
          na[q] = ld24(U6 + (size_t)(lh ? idb : ida) * 768 + l31 * 8);
        }
      }
      float pt[4];
#pragma unroll
      for (int q = 0; q < 4; ++q) {
        const f32x32v r = __builtin_amdgcn_cvt_scalef32_pk32_f32_fp6(ca[q], 1.0f);
        float s0 = 0.f, s1 = 0.f, s2 = 0.f, s3 = 0.f;
#pragma unroll
        for (int j = 0; j < 32; j += 4) { s0 += r[j] * x[j]; s1 += r[j + 1] * x[j + 1]; s2 += r[j + 2] * x[j + 2]; s3 += r[j + 3] * x[j + 3]; }
        pt[q] = (s0 + s1) + (s2 + s3);
      }
#pragma unroll
      for (int i = 0; i < 2; ++i) { const bool up = lane & 2; const float keep = up ? pt[i + 2] : pt[i]; const float send = up ? pt[i] : pt[i + 2]; pt[i] = keep + SWZ_XOR(send, 2); }
      { const bool up = lane & 1; const float keep = up ? pt[1] : pt[0]; const float send = up ? pt[0] : pt[1]; pt[0] = keep + SWZ_XOR(send, 1); }
      float tot = pt[0];
      tot += SWZ_XOR(tot, 4); tot += SWZ_XOR(tot, 8); tot += SWZ_XOR(tot, 16);
      const int srcl = ((lane & 1) << 5) | ((lane & 7) >> 1);
      const float mine = __int_as_float(__builtin_amdgcn_ds_bpermute(srcl << 2, __float_as_int(tot)));
      if ((lane >> 3) == (gi & 7)) { if (gi < 8) hw0 = mine; else hw1 = mine; }
      if (gi < 15) {
#pragma unroll
        for (int q = 0; q < 4; ++q) ca[q] = na[q];
      }
    }
    HW[(size_t)t * 128 + lane] = gu0 * gelu_tanh(hw0 * su0) * sv0; HW[(size_t)t * 128 + 64 + lane] = gu1 * gelu_tanh(hw1 * su1) * sv1;
  }
  for (int t = wg; t < T_; t += nw) {
    const int id0 = IDX[(size_t)t * 128 + lane], id1 = IDX[(size_t)t * 128 + 64 + lane];
    const float hw0 = HW[(size_t)t * 128 + lane], hw1 = HW[(size_t)t * 128 + 64 + lane];
    float acc[32];
#pragma unroll
    for (int j = 0; j < 32; ++j) acc[j] = 0.f;
    {
      u32x6v ca[4];
#pragma unroll
      for (int q = 0; q < 4; ++q) { const int ida = __builtin_amdgcn_readlane(id0, 2 * q), idb = __builtin_amdgcn_readlane(id0, 2 * q + 1); ca[q] = ld24(V6 + (size_t)(lh ? idb : ida) * 768 + l31 * 8); }
      for (int gi = 0; gi < 16; ++gi) {
        u32x6v na[4];
        if (gi < 15) {
          const int idh = (gi + 1 < 8) ? id0 : id1;
#pragma unroll
          for (int q = 0; q < 4; ++q) {
            const int ida = __builtin_amdgcn_readlane(idh, ((gi + 1) & 7) * 8 + 2 * q), idb = __builtin_amdgcn_readlane(idh, ((gi + 1) & 7) * 8 + 2 * q + 1);
            na[q] = ld24(V6 + (size_t)(lh ? idb : ida) * 768 + l31 * 8);
          }
        }
        const float hwh = (gi < 8) ? hw0 : hw1;
#pragma unroll
        for (int q = 0; q < 4; ++q) {
          const float wa = __int_as_float(__builtin_amdgcn_readlane(__float_as_int(hwh), (gi & 7) * 8 + 2 * q));
          const float wb = __int_as_float(__builtin_amdgcn_readlane(__float_as_int(hwh), (gi & 7) * 8 + 2 * q + 1));
          const float w = lh ? wb : wa;
          const f32x32v r = __builtin_amdgcn_cvt_scalef32_pk32_f32_fp6(ca[q], 1.0f);
#pragma unroll
          for (int j = 0; j < 32; ++j) acc[j] += w * r[j];
        }
        if (gi < 15) {
#pragma unroll
          for (int q = 0; q < 4; ++q) ca[q] = na[q];
        }
      }
    }
    const float4* irow = (const float4*)(p.out + (size_t)t * D_ + l31 * 32);
    float y[32]; float sum = 0.f;
#pragma unroll
    for (int i = 0; i < 8; ++i) {
      const float4 v = irow[i];
      y[4 * i] = ALPHA * v.x + xor32_sum(acc[4 * i]); y[4 * i + 1] = ALPHA * v.y + xor32_sum(acc[4 * i + 1]);
      y[4 * i + 2] = ALPHA * v.z + xor32_sum(acc[4 * i + 2]); y[4 * i + 3] = ALPHA * v.w + xor32_sum(acc[4 * i + 3]);
      sum += y[4 * i] + y[4 * i + 1] + y[4 * i + 2] + y[4 * i + 3];
    }
    const float mu = half_sum(sum) * (1.f / D_);
    float vs = 0.f;
#pragma unroll
    for (int j = 0; j < 32; ++j) { y[j] -= mu; vs += y[j] * y[j]; }
    const float rs = rsqrtf(half_sum(vs) * (1.f / D_) + 1e-5f);
    float* orow = (dummy ? (float*)(p.ws + OFF_KVC) + (size_t)(t & 8191) * D_ : p.out + (size_t)t * D_) + l31 * 32;
    const float4* gg = (const float4*)(p.in[I_LNFG] + l31 * 32); const float4* bb = (const float4*)(p.in[I_LNFB] + l31 * 32);
#pragma unroll
    for (int i = 0; i < 8; ++i) {
      if ((i >> 2) == lh) {
        const float4 g4 = gg[i], b4 = bb[i];
        ((float4*)orow)[i] = make_float4(y[4 * i] * rs * g4.x + b4.x, y[4 * i + 1] * rs * g4.y + b4.y, y[4 * i + 2] * rs * g4.z + b4.z, y[4 * i + 3] * rs * g4.w + b4.w);
      }
    }
  }
}

DEV unsigned f2key(float f) { unsigned u = __float_as_uint(f); return u ^ ((unsigned)((int)u >> 31) | 0x80000000u); }
DEV float key2f(unsigned k) { return __uint_as_float((k & 0x80000000u) ? (k ^ 0x80000000u) : ~k); }
DEV void sort16_desc(unsigned (&v)[16]) {
#pragma unroll
  for (int k = 2; k <= 16; k <<= 1) {
#pragma unroll
    for (int j = k >> 1; j > 0; j >>= 1) {
#pragma unroll
      for (int i = 0; i < 16; ++i) {
        const int l = i ^ j;
        if (l > i) {
          const bool desc = ((i & k) == 0);
          const unsigned a = v[i], b = v[l];
          const unsigned hi = a > b ? a : b, lo = a > b ? b : a;
          v[i] = desc ? hi : lo; v[l] = desc ? lo : hi;
        }
      }
    }
  }
}
DEV void merge16_desc(unsigned (&a)[16], const unsigned (&b)[16]) {
#pragma unroll
  for (int i = 0; i < 16; ++i) { const unsigned x = a[i], y = b[15 - i]; a[i] = x > y ? x : y; }
#pragma unroll
  for (int j = 8; j > 0; j >>= 1) {
#pragma unroll
    for (int i = 0; i < 16; ++i) {
      const int l = i ^ j;
      if (l > i) { const unsigned x = a[i], y = a[l]; a[i] = x > y ? x : y; a[l] = x > y ? y : x; }
    }
  }
}


template <int pp>
DEV void qtopk_half(const unsigned char* lds, const bf16_t* SK, int h, int trow, int l31, int lh, unsigned* lists) {
  bf16x8 qf[4];
#pragma unroll
  for (int s = 0; s < 4; ++s) qf[s] = *(const bf16x8*)(lds + trow * 256 + (((pp * 8 + 2 * s + lh) ^ (trow & 15)) << 4));
  unsigned best[16];
#pragma unroll
  for (int i = 0; i < 16; ++i) best[i] = 0u;
#pragma unroll 1
  for (int nb = 0; nb < 4; ++nb) {
    f32x16 S;
#pragma unroll
    for (int r = 0; r < 16; ++r) S[r] = 0.f;
#pragma unroll
    for (int s = 0; s < 4; ++s) {
      const bf16x8 kf = *(const bf16x8*)(SK + ((size_t)((h * 2 + pp) * 128 + 32 * nb + l31)) * 64 + 16 * s + 8 * lh);
      S = __builtin_amdgcn_mfma_f32_32x32x16_bf16(kf, qf[s], S, 0, 0, 0);
    }
    unsigned blk[16];
#pragma unroll
    for (int r = 0; r < 16; ++r) {
      const unsigned n = 32 * nb + (r & 3) + 8 * (r >> 2) + 4 * lh;
      blk[r] = (f2key(S[r]) & ~127u) | n;
    }
    sort16_desc(blk);
    merge16_desc(best, blk);
  }
  unsigned other[16];
#pragma unroll
  for (int i = 0; i < 16; ++i) other[i] = xor32_get(best[i], lh);
  merge16_desc(best, other);
  if (lh == pp) {
#pragma unroll
    for (int i = 0; i < 16; ++i) lists[trow * 32 + pp * 16 + i] = best[i];
  }
}

DEV void ph_peer_qtopk(const Params& p, unsigned char* lds, int wv) {
  const int tid = opaque_tid(wv), lane = tid & 63, w = tid >> 6, wm = w >> 1, wn = w & 1, l31 = lane & 31, lh = lane >> 5;
  const bf16_t* XB = (const bf16_t*)(p.ws + OFF_HB);
  const bf16_t* WQ = (const bf16_t*)(p.ws + W_Q);
  const bf16_t* SK = (const bf16_t*)(p.ws + W_SK);
  int* IDX = (int*)(p.ws + OFF_IDX); float* GP = (float*)(p.ws + OFF_GP);
  unsigned* lists = (unsigned*)(lds + 32768);
  const int nitems = (T_ / 128) * 8;
  for (int l = blockIdx.x >> 3; l < 128; l += (gridDim.x >> 3)) {
    const int m0 = ((blockIdx.x & 7) * 16 + (l >> 3)) * 128, h = l & 7;
    f32x4 acc[4][4];
    mfma_gemm_mainloop16(XB, 1024, WQ, 1024, 1024, m0, h * 128, lds, acc, wv);
    {
      const int l15 = lane & 15, lq = lane >> 4;
#pragma unroll
      for (int i = 0; i < 4; ++i)
#pragma unroll
        for (int j = 0; j < 4; ++j)
#pragma unroll
          for (int r = 0; r < 4; ++r) {
            const int row = wm * 64 + i * 16 + 4 * lq + r, col = wn * 64 + j * 16 + l15;
            *(bf16_t*)(lds + row * 256 + ((((col >> 3) ^ (row & 15))) << 4) + (col & 7) * 2) = f2bf(acc[i][j][r]);
          }
    }
    __syncthreads();
    const int trow = 32 * w + l31;
    qtopk_half<0>(lds, SK, h, trow, l31, lh, lists);
    qtopk_half<1>(lds, SK, h, trow, l31, lh, lists);
    float f1[16], f2v[16];
#pragma unroll
    for (int i = 0; i < 16; ++i) { f1[i] = key2f(lists[trow * 32 + i] & ~127u); f2v[i] = key2f(lists[trow * 32 + 16 + i] & ~127u); }
    unsigned cd[4][16];
    cd[0][0] = (f2key(f1[0] + f2v[0]) & ~255u) | 0u;
    cd[0][1] = (f2key(f1[0] + f2v[1]) & ~255u) | 1u;
    cd[0][2] = (f2key(f1[0] + f2v[2]) & ~255u) | 2u;
    cd[0][3] = (f2key(f1[0] + f2v[3]) & ~255u) | 3u;
    cd[0][4] = (f2key(f1[0] + f2v[4]) & ~255u) | 4u;
    cd[0][5] = (f2key(f1[0] + f2v[5]) & ~255u) | 5u;
    cd[0][6] = (f2key(f1[0] + f2v[6]) & ~255u) | 6u;
    cd[0][7] = (f2key(f1[0] + f2v[7]) & ~255u) | 7u;
    cd[0][8] = (f2key(f1[0] + f2v[8]) & ~255u) | 8u;
    cd[0][9] = (f2key(f1[0] + f2v[9]) & ~255u) | 9u;
    cd[0][10] = (f2key(f1[0] + f2v[10]) & ~255u) | 10u;
    cd[0][11] = (f2key(f1[0] + f2v[11]) & ~255u) | 11u;
    cd[0][12] = (f2key(f1[0] + f2v[12]) & ~255u) | 12u;
    cd[0][13] = (f2key(f1[0] + f2v[13]) & ~255u) | 13u;
    cd[0][14] = (f2key(f1[0] + f2v[14]) & ~255u) | 14u;
    cd[0][15] = (f2key(f1[0] + f2v[15]) & ~255u) | 15u;
    cd[1][0] = (f2key(f1[1] + f2v[0]) & ~255u) | 16u;
    cd[1][1] = (f2key(f1[1] + f2v[1]) & ~255u) | 17u;
    cd[1][2] = (f2key(f1[1] + f2v[2]) & ~255u) | 18u;
    cd[1][3] = (f2key(f1[1] + f2v[3]) & ~255u) | 19u;
    cd[1][4] = (f2key(f1[1] + f2v[4]) & ~255u) | 20u;
    cd[1][5] = (f2key(f1[1] + f2v[5]) & ~255u) | 21u;
    cd[1][6] = (f2key(f1[1] + f2v[6]) & ~255u) | 22u;
    cd[1][7] = (f2key(f1[1] + f2v[7]) & ~255u) | 23u;
    cd[1][8] = (f2key(f1[2] + f2v[0]) & ~255u) | 32u;
    cd[1][9] = (f2key(f1[2] + f2v[1]) & ~255u) | 33u;
    cd[1][10] = (f2key(f1[2] + f2v[2]) & ~255u) | 34u;
    cd[1][11] = (f2key(f1[2] + f2v[3]) & ~255u) | 35u;
    cd[1][12] = (f2key(f1[2] + f2v[4]) & ~255u) | 36u;
    cd[1][13] = (f2key(f1[3] + f2v[0]) & ~255u) | 48u;
    cd[1][14] = (f2key(f1[3] + f2v[1]) & ~255u) | 49u;
    cd[1][15] = (f2key(f1[3] + f2v[2]) & ~255u) | 50u;
    cd[2][0] = (f2key(f1[3] + f2v[3]) & ~255u) | 51u;
    cd[2][1] = (f2key(f1[4] + f2v[0]) & ~255u) | 64u;
    cd[2][2] = (f2key(f1[4] + f2v[1]) & ~255u) | 65u;
    cd[2][3] = (f2key(f1[4] + f2v[2]) & ~255u) | 66u;
    cd[2][4] = (f2key(f1[5] + f2v[0]) & ~255u) | 80u;
    cd[2][5] = (f2key(f1[5] + f2v[1]) & ~255u) | 81u;
    cd[2][6] = (f2key(f1[6] + f2v[0]) & ~255u) | 96u;
    cd[2][7] = (f2key(f1[6] + f2v[1]) & ~255u) | 97u;
    cd[2][8] = (f2key(f1[7] + f2v[0]) & ~255u) | 112u;
    cd[2][9] = (f2key(f1[7] + f2v[1]) & ~255u) | 113u;
    cd[2][10] = (f2key(f1[8] + f2v[0]) & ~255u) | 128u;
    cd[2][11] = (f2key(f1[9] + f2v[0]) & ~255u) | 144u;
    cd[2][12] = (f2key(f1[10] + f2v[0]) & ~255u) | 160u;
    cd[2][13] = (f2key(f1[11] + f2v[0]) & ~255u) | 176u;
    cd[2][14] = (f2key(f1[12] + f2v[0]) & ~255u) | 192u;
    cd[2][15] = (f2key(f1[13] + f2v[0]) & ~255u) | 208u;
    cd[3][0] = (f2key(f1[14] + f2v[0]) & ~255u) | 224u;
    cd[3][1] = (f2key(f1[15] + f2v[0]) & ~255u) | 240u;
    cd[3][2] = 0u;
    cd[3][3] = 0u;
    cd[3][4] = 0u;
    cd[3][5] = 0u;
    cd[3][6] = 0u;
    cd[3][7] = 0u;
    cd[3][8] = 0u;
    cd[3][9] = 0u;
    cd[3][10] = 0u;
    cd[3][11] = 0u;
    cd[3][12] = 0u;
    cd[3][13] = 0u;
    cd[3][14] = 0u;
    cd[3][15] = 0u;
#pragma unroll
    for (int q = 0; q < 4; ++q) sort16_desc(cd[q]);
    merge16_desc(cd[0], cd[1]); merge16_desc(cd[2], cd[3]); merge16_desc(cd[0], cd[2]);
    float ev[16]; float sm = 0.f;
    const float mx = key2f(cd[0][0] & ~255u);
#pragma unroll
    for (int i = 0; i < 16; ++i) { ev[i] = __expf(key2f(cd[0][i] & ~255u) - mx); sm += ev[i]; }
    const float inv = 1.f / sm;
    const size_t ob = (size_t)(m0 + trow) * 128 + h * 16;
#pragma unroll
    for (int i = 0; i < 16; ++i) {
      if ((i >> 3) == lh) {
        const unsigned code = cd[0][i] & 255u;
        const unsigned i1 = lists[trow * 32 + (code >> 4)] & 127u, i2 = lists[trow * 32 + 16 + (code & 15u)] & 127u;
        IDX[ob + i] = (int)(i1 * 128u + i2);
        GP[ob + i] = ev[i] * inv;
      }
    }
    __syncthreads();
  }
}

DEV void ph_merge2(const Params& p, unsigned char* lds, int wv) {
  const bf16_t* GS = (const bf16_t*)p.out; bf16_t* M = (bf16_t*)(p.ws + OFF_M);
  const bf16_t* YN = (const bf16_t*)(p.ws + OFF_YNSA); const bf16_t* YR = (const bf16_t*)(p.ws + OFF_YRWKV);
  const bf16_t* WN = (const bf16_t*)(p.ws + W_N); const bf16_t* WR = (const bf16_t*)(p.ws + W_R);
  for (int l = blockIdx.x >> 3; l < 128; l += (gridDim.x >> 3)) {
    const int m0 = ((blockIdx.x & 7) * 16 + (l >> 3)) * 128, n0 = (l & 7) * 128;
    f32x4 acc[4][4];
    mfma_gemm_mainloop16<true>(YN, 512, WN, 512, 512, m0, n0, lds, acc, wv);
    const int tid = opaque_tid(wv), lane = tid & 63, w = tid >> 6, wm = w >> 1, wn = w & 1, l15 = lane & 15, lq = lane >> 4;
#pragma unroll
    for (int i = 0; i < 4; ++i)
#pragma unroll
      for (int j = 0; j < 4; ++j) {
#pragma unroll
        for (int r = 0; r < 4; ++r) {
          const unsigned t = m0 + wm * 64 + i * 16 + 4 * lq + r, n = n0 + wn * 64 + j * 16 + l15;
          const float g1 = bf2f(GS[t * 2048 + n]), g2 = bf2f(GS[t * 2048 + 1024 + n]);
          acc[i][j][r] *= g1 / fmaxf(g2, 1e-30f);
        }
      }
    mfma_gemm_mainloop16<false>(YR, 512, WR, 512, 512, m0, n0, lds, acc, wv);
#pragma unroll
    for (int i = 0; i < 4; ++i)
#pragma unroll
      for (int j = 0; j < 4; ++j) {
#pragma unroll
        for (int r = 0; r < 4; ++r) {
          const unsigned t = m0 + wm * 64 + i * 16 + 4 * lq + r, n = n0 + wn * 64 + j * 16 + l15;
          M[t * 1024 + n] = f2bf(fmaxf(bf2f(GS[t * 2048 + 1024 + n]), 1e-30f) * acc[i][j][r]);
        }
        __builtin_amdgcn_sched_barrier(0);
      }
  }
}

#define XB_TMO      128
#define XB_XCNT(j)  (256  + 64 * (j))
#define XB_XSUB(j)  (1280 + 64 * (j))
#define XB_XGEN(j)  (2304 + 64 * (j))
#define XB_TOP      3328
#define XB_TOPGEN   3392
#define XCD_BAR_WORDS 3456
#define XB_SPIN_CAP (1u << 22)
#define LAS __attribute__((address_space(3)))
DEV unsigned xb_ld(unsigned* p) { return __hip_atomic_load(p, __ATOMIC_RELAXED, __HIP_MEMORY_SCOPE_AGENT); }
DEV unsigned xb_add(unsigned* p, unsigned v) { return __hip_atomic_fetch_add(p, v, __ATOMIC_RELAXED, __HIP_MEMORY_SCOPE_AGENT); }
DEV unsigned xb_xcc_id() { return (unsigned)__builtin_amdgcn_s_getreg((3 << 11) | 20) & 0xFu; }
#define XB_SPIN(cond, bar) do { unsigned _sp = 0; while (cond) { __builtin_amdgcn_s_sleep(1); \
    if ((++_sp & 255u) == 0u) { if (xb_ld(&(bar)[XB_TMO])) break; if (_sp > XB_SPIN_CAP) { atomicAdd(&(bar)[XB_TMO], 1u); break; } } } } while (0)
struct XcdBarrier { unsigned* bar; unsigned x; volatile LAS unsigned* st; int wv; };
DEV XcdBarrier xcd_barrier_post(unsigned* bar, volatile LAS unsigned* st) {
  XcdBarrier b; b.bar = bar; b.x = xb_xcc_id(); b.st = st;
  if (threadIdx.x == 0) (void)xb_add(&bar[XB_XCNT(b.x)], 1u);
  return b;
}
DEV void xcd_barrier_complete(unsigned* bar, unsigned x, unsigned& nloc, unsigned& nx) {
  const unsigned G = gridDim.x * gridDim.y * gridDim.z;
  unsigned sum, cnt, mine, sp = 0u;
  for (;;) {
    sum = 0u; cnt = 0u; mine = 0u;
#pragma unroll
    for (unsigned j = 0; j < 16; ++j) { const unsigned c = xb_ld(&bar[XB_XCNT(j)]); sum += c; cnt += (c > 0u) ? 1u : 0u; mine = (j == x) ? c : mine; }
    if (sum == G) break;
    __builtin_amdgcn_s_sleep(1);
    if ((++sp & 255u) == 0u) { if (xb_ld(&bar[XB_TMO])) break; if (sp > XB_SPIN_CAP) { atomicAdd(&bar[XB_TMO], 1u); break; } }
  }
  nloc = mine > 0u ? mine : 1u; nx = cnt > 0u ? cnt : 1u;
}
DEV void xcd_barrier(const XcdBarrier& b) {
  asm volatile("s_waitcnt vmcnt(0)" ::: "memory");
  __syncthreads();
  if (opaque_tid(b.wv) == 0) {
    unsigned* bar = b.bar;
    __builtin_amdgcn_s_waitcnt(0);
    unsigned nloc = b.st[0], nx = b.st[1];
    if (nloc == 0u) { xcd_barrier_complete(bar, b.x, nloc, nx); b.st[0] = nloc; b.st[1] = nx; }
    const unsigned old = xb_add(&bar[XB_XSUB(b.x)], 1u);
    const unsigned gen = old / nloc;
    if (old + 1u == (gen + 1u) * nloc) {
      __builtin_amdgcn_fence(__ATOMIC_RELEASE, "agent");
      asm volatile("s_waitcnt vmcnt(0)" ::: "memory");
      const unsigned og = xb_add(&bar[XB_TOP], 1u);
      const unsigned tg = og / nx;
      if (og + 1u == (tg + 1u) * nx) xb_add(&bar[XB_TOPGEN], 1u);
      else XB_SPIN(xb_ld(&bar[XB_TOPGEN]) == tg, bar);
      __builtin_amdgcn_fence(__ATOMIC_ACQUIRE, "agent");
      xb_add(&bar[XB_XGEN(b.x)], 1u);
      asm volatile("s_waitcnt vmcnt(0)" ::: "memory");
    } else {
      XB_SPIN(xb_ld(&bar[XB_XGEN(b.x)]) == gen, bar);
      __builtin_amdgcn_fence(__ATOMIC_ACQUIRE, "agent");
      asm volatile("s_waitcnt vmcnt(0)" ::: "memory");
    }
  }
  __syncthreads();
}

#define REP_Z 1
#define ZPB 0
#define REP_CMP 1
#define REP_PREP 1
#define REP_NSA 1
#define REP_SCAN 1
#define REP_POSTGS 1
#define REP_QTOPK 1
#define REP_GATHER 1
#define REP_P0 1
#define REP_BAR 0
#define REP_P7 1
#define REP_POST 1
#define REP_MERGE 1
#define REP_OUT 1
__global__ void __launch_bounds__(256, 2) mega(Params p) {
  cg::grid_group grid = cg::this_grid();
  const int wv = __builtin_amdgcn_readfirstlane((int)(threadIdx.x >> 6));
  __shared__ __attribute__((aligned(16))) float lds[16384 + 4];
  unsigned char* ldsb = (unsigned char*)lds;
  bf16_t* HB = (bf16_t*)(p.ws + OFF_HB);
  unsigned* ctl = (unsigned*)(p.ws + OFF_CTL);
  if (threadIdx.x < 4) lds[16384 + threadIdx.x] = 0.f;
  __syncthreads();
  XcdBarrier xb = xcd_barrier_post((unsigned*)(p.ws + OFF_BAR), (volatile LAS unsigned*)(lds + 16384)); xb.wv = wv;
  for (int rep = 0; rep < REP_P0; ++rep) {
  ph_ln_wave(p.in[I_X], p.in[I_LNIN_G], p.in[I_LNIN_B], nullptr, HB, wv);
  {
    int it0 = 0; const int gsz = gridDim.x;
    conv_wT(p.in[I_WIN], DIN, 0, 1024, NZ, 3200, (bf16_t*)(p.ws + W_IN), lds, it0, gsz, wv);
    conv_wT(p.in[I_WIN], DIN, C_MG, 1024, 2048, 2048, (bf16_t*)(p.ws + W_G), lds, it0, gsz, wv);
    conv_wT(p.in[I_WON], 1024, 0, 512, 1024, 1024, (bf16_t*)(p.ws + W_N), lds, it0, gsz, wv);
    conv_wT(p.in[I_WOR], 1024, 0, 512, 1024, 1024, (bf16_t*)(p.ws + W_R), lds, it0, gsz, wv);
    conv_wT(p.in[I_WOUT], 1024, 0, 1024, 1024, 1024, (bf16_t*)(p.ws + W_OUT), lds, it0, gsz, wv);
    conv_wT(p.in[I_PWQ], 1024, 0, 1024, 1024, 1024, (bf16_t*)(p.ws + W_Q), lds, it0, gsz, wv);
    conv_wT(p.in[I_W2], 512, 0, 64, 512, 512, (bf16_t*)(p.ws + W_LW), lds, it0, gsz, wv);
    conv_wT(p.in[I_A2], 512, 0, 64, 512, 512, (bf16_t*)(p.ws + W_LA), lds, it0, gsz, wv);
    conv_wT(p.in[I_G2], 512, 0, 128, 512, 512, (bf16_t*)(p.ws + W_LG), lds, it0, gsz, wv);
    {
      bf16_t* W1C = (bf16_t*)(p.ws + W_C1T);
      for (int i = blockIdx.x * 256 + opaque_tid(wv); i < 2 * 256 * 256; i += gsz * 256) {
        const int n = i & 255, kc = (i >> 8) & 255, kv = i >> 16;
        const float* src = p.in[I_CW1] + ((size_t)kv * 2048 + kc * 8) * 256 + n;
        float f[8];
#pragma unroll
        for (int j = 0; j < 8; ++j) f[j] = src[j * 256];
        *(uint4*)(W1C + (size_t)i * 8) = pack8f(f);
      }
    }
    conv_wT(p.in[I_CW2], 64, 0, 256, 64, 64, (bf16_t*)(p.ws + W_C2T), lds, it0, gsz, wv);
    conv_wT(p.in[I_CW2] + 256 * 64, 64, 0, 256, 64, 64, (bf16_t*)(p.ws + W_C2T) + 64 * 256, lds, it0, gsz, wv);
    {
      float* C1 = (float*)(p.ws + W_C1);
      const int ln = opaque_tid(wv) & 63;
      for (int o = blockIdx.x * 4 + wv; o < 512; o += gsz * 4) {
        const int kv = o >> 8, n = o & 255;
        float a = 0.f;
#pragma unroll 16
        for (int e = ln; e < 2048; e += 64) a += p.in[I_CPOS][kv * 2048 + e] * p.in[I_CW1][((size_t)kv * 2048 + e) * 256 + n];
        a = wave_sum(a);
        if (ln == 0) C1[o] = a + p.in[I_CB1][o];
      }
    }
    { bf16_t* SK = (bf16_t*)(p.ws + W_SK); for (int i = blockIdx.x * 256 + opaque_tid(wv); i < 8 * 2 * 128 * 64; i += gsz * 256) SK[i] = f2bf(p.in[I_PSK][i]); }
  }
  }
  if (p.ws == nullptr) grid.sync();
  xcd_barrier(xb);
  {
    ZEpi e{(bf16_t*)(p.ws + OFF_Q), (bf16_t*)(p.ws + OFF_KVC), (bf16_t*)(p.ws + OFF_KSLC), (bf16_t*)(p.ws + OFF_KWIN),
           (bf16_t*)(p.ws + OFF_VSLCT), (bf16_t*)(p.ws + OFF_VWINT), (bf16_t*)p.out, (float*)(p.ws + OFF_GATE)};
    for (int rep = 0; rep < REP_Z - 1; ++rep) { mfma_gemm16<ZPB>(HB, 1024, (const bf16_t*)(p.ws + W_IN), 1024, 1024, T_, 3072, ldsb, e, wv, 12); ph_ztail(p, e, wv); }
    { mfma_gemm16(HB, 1024, (const bf16_t*)(p.ws + W_IN), 1024, 1024, T_, 3072, ldsb, e, wv, 12); ph_ztail(p, e, wv); }
  }
  xcd_barrier(xb);
  for (int rep = 0; rep < REP_CMP; ++rep) ph_cmp2(p, ldsb, wv);
  for (int rep = 0; rep < REP_PREP; ++rep) ph_prep2(p, ldsb, wv);
  xcd_barrier(xb);
  for (int rep = 0; rep < REP_SCAN; ++rep) ph_scan2(p, lds, wv);
  for (int rep = 0; rep < REP_NSA; ++rep) ph_nsa_mfma(p, ldsb, ctl + rep, wv);
  xcd_barrier(xb);
  for (int rep = 0; rep < REP_POST; ++rep) ph_post_wave(p, wv);
  {
    bf16_t* GS = (bf16_t*)p.out;
    auto e = elem_epi([=](int t, int n, float v) { GS[(unsigned)(t * 2048 + n)] = f2bf(sigm(v)); });
    for (int rep = 0; rep < REP_POSTGS; ++rep) mfma_gemm16(HB, 1024, (const bf16_t*)(p.ws + W_G), 1024, 1024, T_, 2048, ldsb, e, wv, 8);
  }
  xcd_barrier(xb);
  for (int rep = 0; rep < REP_MERGE; ++rep) ph_merge2(p, ldsb, wv);
  xcd_barrier(xb);
  {
    float* Y1 = p.out;
    auto e = elem_epi([=](int t, int n, float v) { Y1[(unsigned)(t * 1024 + n)] = ALPHA * bf2f(HB[(unsigned)(t * 1024 + n)]) + v; });
    for (int rep = 0; rep < REP_OUT; ++rep) mfma_gemm16((const bf16_t*)(p.ws + OFF_M), 1024, (const bf16_t*)(p.ws + W_OUT), 1024, 1024, T_, 1024, ldsb, e, wv, 8);
  }
  xcd_barrier(xb);
  for (int rep = REP_P7 - 1; rep >= 0; --rep) {
    if (rep) ph_ln_wave(p.out, p.in[I_LNMG], p.in[I_LNMB], nullptr, (bf16_t*)(p.ws + OFF_KVC), wv);
    else ph_ln_wave(p.out, p.in[I_LNMG], p.in[I_LNMB], p.out, HB, wv);
    ph_conv_tables6(p, wv);
  }
  xcd_barrier(xb);
  for (int rep = 0; rep < REP_BAR; ++rep) xcd_barrier(xb);
  for (int rep = 0; rep < REP_QTOPK; ++rep) ph_peer_qtopk(p, ldsb, wv);
  xcd_barrier(xb);
  for (int rep = REP_GATHER - 1; rep >= 0; --rep) ph_peer_gather6(p, rep, wv);
}

extern "C" void kernel_launch(void* const* d_in, const int* in_sizes, int n_in, void* d_out, int out_size, void* d_ws, size_t ws_size, hipStream_t stream) {
  static int grid_blocks = 0;
  if (!grid_blocks) {
    int dev = 0, cus = 0, per_cu = 0;
    hipGetDevice(&dev);
    hipDeviceGetAttribute(&cus, hipDeviceAttributeMultiprocessorCount, dev);
    hipOccupancyMaxActiveBlocksPerMultiprocessor(&per_cu, mega, 256, 0);
    if (per_cu > 4) per_cu = 4;
    if (per_cu < 1) per_cu = 1;
    grid_blocks = cus * per_cu;
  }
  Params p{};
  for (int i = 0; i < 32; ++i) p.in[i] = (const float*)d_in[i];
  p.out = (float*)d_out;
  p.ws = (unsigned char*)d_ws;
  hipMemsetAsync((char*)d_ws + OFF_BAR, 0, 16384, stream);
  void* args[] = {&p};
  hipError_t e = hipLaunchCooperativeKernel((void*)mega, dim3(grid_blocks), dim3(256), args, 0, stream);
  if (e != hipSuccess) fprintf(stderr, "cooperative launch failed: %s (grid %d)\n", hipGetErrorString(e), grid_blocks);
}
```
